# Optimizing an MI355X kernel written in HIP

```python
import jax
import jax.numpy as jnp
from jax import lax
import numpy as np


D_MODEL = 1024
BATCH = 8
SEQ = 8192
DEPTH = 1

CTX_LEN = 256
GRID_W = 64
EPS = 1e-6

POOL_WINDOWS = (2, 4, 8, 16)
POOL_GROUPS = len(POOL_WINDOWS)
POOL_WIDTH = D_MODEL // 2
POOL_GC = POOL_WIDTH // POOL_GROUPS

M_HEADS = 4
M_HEAD_DIM = D_MODEL // 8
M_WIDTH = M_HEADS * M_HEAD_DIM
CONV_W = 3
CHUNK = 128
F_BIAS_INIT = 3.0

OFF_POOL = 0
OFF_Q = OFF_POOL + POOL_WIDTH
OFF_K = OFF_Q + M_WIDTH
OFF_V = OFF_K + M_WIDTH
OFF_O = OFF_V + M_WIDTH
OFF_GATE = OFF_O + M_WIDTH
N_GATE = 4 * M_HEADS
OFF_MERGE = OFF_GATE + N_GATE
IN_WIDTH = OFF_MERGE + 2 * D_MODEL

N_EXPERTS = 32
TOP_K = 4
D_FF = D_MODEL
SWIGLU_LIMIT = 7.0
SWIGLU_ALPHA = 1.702
MOE_BLOCK = 512

kernel_name = 'hybrid_pool_mlstm_moe_dit'


def rmsnorm(x, w):
    xf = x.astype(jnp.float32)
    y = xf * lax.rsqrt(jnp.mean(xf * xf, axis=-1, keepdims=True) + EPS)
    return (y * w.astype(jnp.float32)).astype(x.dtype)


def modulate(h, shift, scale):
    return h * (1.0 + scale) + shift


def centred_pool(u):
    W = u.shape[2]
    pos = np.arange(W)
    outs = []
    for g, win in enumerate(POOL_WINDOWS):
        ug = u[..., g * POOL_GC:(g + 1) * POOL_GC].astype(jnp.float32)
        cs = jnp.pad(jnp.cumsum(ug, axis=2), ((0, 0), (0, 0), (1, 0), (0, 0)))
        lo = np.clip(pos - win // 2, 0, W)
        hi = np.clip(pos + win // 2, 0, W)
        cnt = (hi - lo).astype(np.float32)[:, None]
        mean = (jnp.take(cs, hi, axis=2) - jnp.take(cs, lo, axis=2)) / cnt
        outs.append(mean - ug)
    return jnp.concatenate(outs, axis=-1).astype(u.dtype)


def short_conv(u, w, b):
    L = u.shape[1]
    pad = CONV_W // 2
    up = jnp.pad(u, ((0, 0), (pad, pad), (0, 0)))
    acc = b
    for j in range(CONV_W):
        acc = acc + up[:, j:j + L] * w[j]
    return jax.nn.silu(acc)


def to_heads(a):
    B, L, _ = a.shape
    return a.reshape(B, L, M_HEADS, M_HEAD_DIM).transpose(0, 2, 1, 3).astype(jnp.float32)


def mlstm_inputs(p, conv_w, conv_b, gate_b):
    qk = short_conv(p[..., OFF_Q:OFF_V], conv_w, conv_b)
    q = to_heads(qk[..., :M_WIDTH]) * (M_HEAD_DIM ** -0.5)
    k = to_heads(qk[..., M_WIDTH:])
    v = to_heads(p[..., OFF_V:OFF_O])
    B, L, _ = p.shape
    g = (p[..., OFF_GATE:OFF_MERGE] + gate_b).astype(jnp.float32)
    g = g.reshape(B, L, 4, M_HEADS).transpose(2, 0, 3, 1)
    return (q, k, v, g[0], jax.nn.log_sigmoid(g[1]), g[2], jax.nn.log_sigmoid(g[3]))


def zero_state(B):
    return (jnp.zeros((B, M_HEADS, M_HEAD_DIM, M_HEAD_DIM), jnp.float32),
            jnp.zeros((B, M_HEADS, M_HEAD_DIM), jnp.float32),
            jnp.zeros((B, M_HEADS), jnp.float32))


def mlstm_scan(q, k, v, ig, lf, state):
    B, H, L, Dh = q.shape
    N = L // CHUNK

    def chunks(a):
        return jnp.moveaxis(a.reshape(a.shape[:2] + (N, CHUNK) + a.shape[3:]), 2, 0)

    mask = jnp.asarray(np.tril(np.ones((CHUNK, CHUNK), dtype=bool)))

    def step(carry, xs):
        C, n, m = carry
        qc, kc, vc, ic, fc = xs
        b = jnp.cumsum(fc, axis=-1)
        logw = jnp.where(mask, b[..., :, None] - b[..., None, :] + ic[..., None, :], -jnp.inf)
        m_inter = b + m[..., None]
        m_t = jnp.maximum(jnp.max(logw, axis=-1), m_inter)
        s = jnp.einsum('bhtd,bhsd->bhts', qc, kc) * jnp.exp(logw - m_t[..., None])
        decay = jnp.exp(m_inter - m_t)
        num = jnp.einsum('bhts,bhsd->bhtd', s, vc) + decay[..., None] * jnp.einsum('bhtk,bhkv->bhtv', qc, C)
        den = jnp.sum(s, axis=-1) + decay * jnp.einsum('bhtk,bhk->bht', qc, n)
        h = num / jnp.maximum(jnp.abs(den), jnp.exp(-m_t))[..., None]
        btot = b[..., -1]
        log_a = btot[..., None] - b + ic
        m_new = jnp.maximum(btot + m, jnp.max(log_a, axis=-1))
        a = jnp.exp(log_a - m_new[..., None])
        cd = jnp.exp(btot + m - m_new)
        C_new = cd[..., None, None] * C + jnp.einsum('bhs,bhsk,bhsv->bhkv', a, kc, vc)
        n_new = cd[..., None] * n + jnp.einsum('bhs,bhsk->bhk', a, kc)
        return (C_new, n_new, m_new), h

    state, h = lax.scan(step, state, (chunks(q), chunks(k), chunks(v), chunks(ig), chunks(lf)))
    return jnp.moveaxis(h, 0, 2).reshape(B, H, L, Dh), state


def mlstm_bidir(q, k, v, i_f, lf_f, i_b, lf_b, init_f, init_b):
    h_f, st_f = mlstm_scan(q, k, v, i_f, lf_f, init_f)
    fl = lambda a: jnp.flip(a, axis=2)
    h_b, st_b = mlstm_scan(fl(q), fl(k), fl(v), fl(i_b), fl(lf_b), init_b)
    return h_f + fl(h_b), st_f, st_b


def mixer_merge(p, pooled, h_m, w_pool, pool_scale, hnorm_w, w_bp, w_bm, w_out):
    B, L, _ = p.shape
    pg = pooled.reshape(B, L, POOL_GROUPS, POOL_GC)
    ya = jnp.einsum('blgc,gcd->blgd', pg, w_pool).reshape(B, L, POOL_WIDTH) * pool_scale
    hn = h_m * lax.rsqrt(jnp.mean(h_m * h_m, axis=-1, keepdims=True) + EPS)
    hn = hn.transpose(0, 2, 1, 3).reshape(B, L, M_WIDTH).astype(p.dtype) * hnorm_w
    yb = hn * jax.nn.sigmoid(p[..., OFF_O:OFF_GATE])
    ga = jax.nn.sigmoid(p[..., OFF_MERGE:OFF_MERGE + D_MODEL])
    gb = jax.nn.sigmoid(p[..., OFF_MERGE + D_MODEL:])
    y = ga * (ya @ w_bp) + gb * (yb @ w_bm)
    return y @ w_out


def moe(h, w_router, b_router, w1, b1, w2, b2):
    shape = h.shape
    x = h.reshape(-1, D_MODEL)
    T = x.shape[0]
    logits = (x @ w_router + b_router).astype(jnp.float32)
    top_v, top_i = lax.top_k(logits, TOP_K)
    top_w = jax.nn.softmax(top_v, axis=-1)
    TK = T * TOP_K
    flat_e = top_i.reshape(-1)
    flat_t = jnp.arange(TK, dtype=jnp.int32) // TOP_K
    flat_w = top_w.reshape(-1)
    order = jnp.argsort(flat_e)
    se = flat_e[order]
    counts = jnp.bincount(flat_e, length=N_EXPERTS)
    starts = jnp.cumsum(counts) - counts
    pcounts = (counts + MOE_BLOCK - 1) // MOE_BLOCK * MOE_BLOCK
    pends = jnp.cumsum(pcounts)
    pstarts = pends - pcounts
    dest = pstarts[se] + jnp.arange(TK, dtype=jnp.int32) - starts[se]
    n_blocks = (TK + MOE_BLOCK - 1) // MOE_BLOCK + N_EXPERTS
    row_tok = jnp.full((n_blocks * MOE_BLOCK,), T, jnp.int32).at[dest].set(flat_t[order])
    row_w = jnp.zeros((n_blocks * MOE_BLOCK,), jnp.float32).at[dest].set(flat_w[order])
    block_e = jnp.minimum(jnp.searchsorted(pends, jnp.arange(n_blocks) * MOE_BLOCK, side='right'),
                          N_EXPERTS - 1).astype(jnp.int32)
    x_pad = jnp.concatenate([x, jnp.zeros((1, D_MODEL), x.dtype)], axis=0)

    def block(y, xs):
        e, rows, wts = xs
        gu = x_pad[rows] @ w1[e] + b1[e]
        gate = jnp.minimum(gu[..., :D_FF], SWIGLU_LIMIT)
        up = jnp.clip(gu[..., D_FF:], -SWIGLU_LIMIT, SWIGLU_LIMIT)
        act = (up + 1.0) * gate * jax.nn.sigmoid(SWIGLU_ALPHA * gate)
        out = act @ w2[e] + b2[e]
        return y.at[rows].add(out * wts[:, None].astype(out.dtype)), None

    y0 = jnp.zeros((T + 1, D_MODEL), x.dtype)
    y, _ = lax.scan(block, y0, (block_e, row_tok.reshape(n_blocks, MOE_BLOCK),
                                row_w.reshape(n_blocks, MOE_BLOCK)))
    return y[:T].reshape(shape)


def setup_inputs(seed: int = 0) -> dict:
    key = jax.random.key(seed)
    ks = jax.random.split(key, 26)
    nrm = lambda k, s, sc: jax.random.normal(k, s, jnp.float32) * sc
    D, L_ = D_MODEL, DEPTH
    gate_base = jnp.concatenate([jnp.zeros((M_HEADS,)), jnp.full((M_HEADS,), F_BIAS_INIT),
                                 jnp.zeros((M_HEADS,)), jnp.full((M_HEADS,), F_BIAS_INIT)]).astype(jnp.float32)
    return {
        'x': nrm(ks[0], (BATCH, SEQ, D), 1.0),
        'c': nrm(ks[1], (BATCH, D), 1.0),
        'ctx': nrm(ks[2], (BATCH, CTX_LEN, D), 1.0),
        'c_ctx': nrm(ks[3], (D,), 1.0),
        'w_ada': nrm(ks[4], (L_, D, 6 * D), 0.5 * D ** -0.5),
        'b_ada': nrm(ks[5], (L_, 6 * D), 0.01),
        'norm1_w': 1.0 + nrm(ks[6], (L_, D), 0.01),
        'w_in': nrm(ks[7], (L_, D, IN_WIDTH), D ** -0.5),
        'gate_b': gate_base + nrm(ks[8], (L_, N_GATE), 0.1),
        'conv_w': nrm(ks[9], (L_, CONV_W, 2 * M_WIDTH), CONV_W ** -0.5),
        'conv_b': nrm(ks[10], (L_, 2 * M_WIDTH), 0.01),
        'w_pool': nrm(ks[11], (L_, POOL_GROUPS, POOL_GC, POOL_GC), POOL_GC ** -0.5),
        'pool_scale': 1.0 + nrm(ks[12], (L_, POOL_WIDTH), 0.1),
        'hnorm_w': 1.0 + nrm(ks[13], (L_, M_WIDTH), 0.01),
        'w_bp': nrm(ks[14], (L_, POOL_WIDTH, D), POOL_WIDTH ** -0.5),
        'w_bm': nrm(ks[15], (L_, M_WIDTH, D), M_WIDTH ** -0.5),
        'w_out': nrm(ks[16], (L_, D, D), D ** -0.5),
        'norm2_w': 1.0 + nrm(ks[17], (L_, D), 0.01),
        'w_router': nrm(ks[18], (L_, D, N_EXPERTS), D ** -0.5),
        'b_router': nrm(ks[19], (L_, N_EXPERTS), 0.01),
        'w1': nrm(ks[20], (L_, N_EXPERTS, D, 2 * D_FF), D ** -0.5),
        'b1': nrm(ks[21], (L_, N_EXPERTS, 2 * D_FF), 0.01),
        'w2': nrm(ks[22], (L_, N_EXPERTS, D_FF, D), D_FF ** -0.5),
        'b2': nrm(ks[23], (L_, N_EXPERTS, D), 0.01),
        'final_norm_w': 1.0 + nrm(ks[24], (D,), 0.01),
    }


def reference(x, c, ctx, c_ctx, w_ada, b_ada, norm1_w, w_in, gate_b, conv_w, conv_b, w_pool,
              pool_scale, hnorm_w, w_bp, w_bm, w_out, norm2_w, w_router, b_router, w1, b1, w2, b2,
              final_norm_w):
    B, L, _ = x.shape
    rows = L // GRID_W
    n_ctx = ctx.shape[1]
    sc = jax.nn.silu(c)
    scx = jax.nn.silu(c_ctx)
    for layer in range(DEPTH):
        mod = (sc @ w_ada[layer] + b_ada[layer])[:, None, :]
        mod_c = scx @ w_ada[layer] + b_ada[layer]
        sh1, s1, g1, sh2, s2, g2 = jnp.split(mod, 6, axis=-1)
        csh1, cs1, cg1, csh2, cs2, cg2 = jnp.split(mod_c, 6, axis=-1)

        p_lat = modulate(rmsnorm(x, norm1_w[layer]), sh1, s1) @ w_in[layer]
        p_ctx = modulate(rmsnorm(ctx, norm1_w[layer]), csh1, cs1) @ w_in[layer]
        ctx_in = mlstm_inputs(p_ctx, conv_w[layer], conv_b[layer], gate_b[layer])
        lat_in = mlstm_inputs(p_lat, conv_w[layer], conv_b[layer], gate_b[layer])
        z = zero_state(B)
        h_ctx, st_f, st_b = mlstm_bidir(*ctx_in, z, z)
        h_lat, _, _ = mlstm_bidir(*lat_in, st_f, st_b)
        pooled = centred_pool(p_lat[..., :POOL_WIDTH].reshape(B, rows, GRID_W, POOL_WIDTH))
        pooled = pooled.reshape(B, L, POOL_WIDTH)
        x = x + g1 * mixer_merge(p_lat, pooled, h_lat, w_pool[layer], pool_scale[layer], hnorm_w[layer],
                                 w_bp[layer], w_bm[layer], w_out[layer])
        if layer < DEPTH - 1:
            pooled_c = centred_pool(p_ctx[:, None, :, :POOL_WIDTH]).reshape(B, n_ctx, POOL_WIDTH)
            ctx = ctx + cg1 * mixer_merge(p_ctx, pooled_c, h_ctx, w_pool[layer], pool_scale[layer],
                                          hnorm_w[layer], w_bp[layer], w_bm[layer], w_out[layer])
            ctx = ctx + cg2 * moe(modulate(rmsnorm(ctx, norm2_w[layer]), csh2, cs2), w_router[layer],
                                  b_router[layer], w1[layer], b1[layer], w2[layer], b2[layer])

        x = x + g2 * moe(modulate(rmsnorm(x, norm2_w[layer]), sh2, s2), w_router[layer], b_router[layer],
                         w1[layer], b1[layer], w2[layer], b2[layer])
    return rmsnorm(x, final_norm_w)
```

```cpp
#include <hip/hip_runtime.h>
#include <cstdio>
#include <cstdint>

#ifndef MK_MULTI
#define MK_MULTI 0
#endif

#define LAS __attribute__((address_space(3)))
#define GAS __attribute__((address_space(1)))
typedef unsigned short bf16;
typedef short bf16x8 __attribute__((ext_vector_type(8)));
typedef float f32x4 __attribute__((ext_vector_type(4)));
typedef float f32x2 __attribute__((ext_vector_type(2)));
typedef unsigned u32x4 __attribute__((ext_vector_type(4)));
typedef unsigned u32x2 __attribute__((ext_vector_type(2)));

constexpr int D = 1024, NBATCH = 8, SEQ = 8192, T = NBATCH * SEQ, CTXL = 256, TCX = NBATCH * CTXL, TA = T + TCX;
constexpr int INW = 4624;
constexpr int NEXP = 32, NGRP = 64;
constexpr int XSPLIT = 30720;
constexpr int CX_MIN = 121, CX_MAX = 128;
constexpr int MAXROWS = T * 4 + NGRP * 256;
constexpr int NPHASE = 16;
constexpr float EPS = 1e-6f;

constexpr size_t MiB = 1u << 20;
constexpr size_t WS_CTL = 0, CTL_BYTES = 1 * MiB;
constexpr size_t WS_MOD = 1 * MiB;
constexpr size_t WS_ENT_G = 2 * MiB, WS_ENT_POS = 3 * MiB, WS_ENT_W = 4 * MiB;
constexpr size_t WS_ROW_TOK = 5 * MiB;
constexpr size_t WS_TOK_ROW = 9 * MiB;
constexpr size_t WS_CBASE = 6 * MiB + 512 * 1024;
constexpr size_t WS_MOETAB = 10 * MiB + 512 * 1024;
constexpr size_t WS_GATES = 11 * MiB;
constexpr size_t WS_WIN_T = 16 * MiB;
constexpr size_t WS_WPA_T = 26 * MiB, WS_WBM_T = 27 * MiB, WS_WOUT_T = 28 * MiB;
constexpr size_t WS_WG_T = 30 * MiB;
constexpr size_t WS_WR_T = 31 * MiB;
constexpr size_t WS_GS = 32 * MiB;
constexpr size_t WS_CHK = 39 * MiB;
constexpr size_t WS_GTILE = 39 * MiB + 512 * 1024;
constexpr size_t WS_XN = 40 * MiB;
constexpr size_t WS_QKC = 40 * MiB, WS_POOLED = 40 * MiB, WS_YB = 104 * MiB;
constexpr size_t WS_PQK = 172 * MiB;
constexpr size_t WS_HF = 172 * MiB, WS_HB = 236 * MiB, WS_Y = 172 * MiB;
constexpr size_t WS_PPOOL = 304 * MiB, WS_PV = 368 * MiB, WS_PO = 434 * MiB, WS_PMERGE = 498 * MiB;
constexpr size_t WS_W1T = 754 * MiB, WS_W2T = 882 * MiB;
constexpr size_t WS_ACT = 40 * MiB, WS_H2 = 626 * MiB, WS_OUTK = 585 * MiB;
constexpr size_t WS_X1B = 946 * MiB;
constexpr size_t WS_END = 1014 * MiB;
static_assert((size_t)MAXROWS * 2048 <= (626 - 40) * MiB, "ACT fits");
constexpr int CW_BAR = 4096;
constexpr int CW_GCNT = 16384;

constexpr int LDS_MAIN = 131072, LDS_BYTES = 147456;
constexpr int LM_BAR = 16368, LM_PSTART = 8704, LM_CX = 8704 + 272, LM_TILEG = 9216;

__device__ __forceinline__ unsigned f2bf(float f) { unsigned u = __builtin_bit_cast(unsigned, f); return (u + 0x7fffu + ((u >> 16) & 1u)) >> 16; }
__device__ __forceinline__ unsigned pk2(float lo, float hi) { return f2bf(lo) | (f2bf(hi) << 16); }
__device__ __forceinline__ float bflo(unsigned w) { return __uint_as_float(w << 16); }
__device__ __forceinline__ float bfhi(unsigned w) { return __uint_as_float(w & 0xffff0000u); }
__device__ __forceinline__ float bf2f(bf16 h) { return __uint_as_float(((unsigned)h) << 16); }
__device__ __forceinline__ float fexp_(float x) { return __builtin_amdgcn_exp2f(x * 1.4426950408889634f); }
__device__ __forceinline__ float frcp_(float x) { return __builtin_amdgcn_rcpf(x); }
__device__ __forceinline__ float sigmoidf_(float x) { return frcp_(1.0f + fexp_(-x)); }
__device__ __forceinline__ float wave_sum(float v) {
#pragma unroll
    for (int o = 1; o < 64; o <<= 1) v += __shfl_xor(v, o);
    return v;
}
#define LDS_WAIT() asm volatile("s_waitcnt lgkmcnt(0)" ::: "memory")
#define VM_WAIT() asm volatile("s_waitcnt vmcnt(0)" ::: "memory")
#define LDS_BARRIER() do { asm volatile("s_waitcnt lgkmcnt(0)" ::: "memory"); __builtin_amdgcn_s_barrier(); asm volatile("" ::: "memory"); } while (0)

#define XB_TMO      128
#define XB_XCNT(j)  (256  + 64 * (j))
#define XB_XSUB(j)  (1280 + 64 * (j))
#define XB_XGEN(j)  (2304 + 64 * (j))
#define XB_TOP      3328
#define XB_TOPGEN   3392
#define XCD_BAR_WORDS 3456
#define XB_SPIN_CAP (1u << 18)
__device__ __forceinline__ unsigned xb_ld(unsigned* p)              { return __hip_atomic_load(p, __ATOMIC_RELAXED, __HIP_MEMORY_SCOPE_AGENT); }
__device__ __forceinline__ unsigned xb_add(unsigned* p, unsigned v) { return __hip_atomic_fetch_add(p, v, __ATOMIC_RELAXED, __HIP_MEMORY_SCOPE_AGENT); }
__device__ __forceinline__ unsigned xb_xcc_id() { return (unsigned)__builtin_amdgcn_s_getreg((3 << 11) | 20) & 0xFu; }
#define XB_SPIN(cond, bar) do { unsigned _sp = 0; while (cond) { __builtin_amdgcn_s_sleep(1); \
    if ((++_sp & 255u) == 0u) { if (xb_ld(&(bar)[XB_TMO])) break; if (_sp > XB_SPIN_CAP) { atomicAdd(&(bar)[XB_TMO], 1u); break; } } } } while (0)
struct XcdBarrier { unsigned* bar; unsigned x; volatile LAS unsigned* st; };
__device__ __forceinline__ XcdBarrier xcd_barrier_post(unsigned* bar, volatile LAS unsigned* st) {
    XcdBarrier b; b.bar = bar; b.x = xb_xcc_id(); b.st = st;
    if (threadIdx.x == 0) (void)xb_add(&bar[XB_XCNT(b.x)], 1u);
    return b;
}
__device__ __forceinline__ void xcd_barrier_complete(unsigned* bar, unsigned x, unsigned& nloc, unsigned& nx) {
    const unsigned G = gridDim.x * gridDim.y * gridDim.z;
    unsigned sum, cnt, mine, sp = 0u;
    for (;;) {
        sum = 0u; cnt = 0u; mine = 0u;
#pragma unroll
        for (unsigned j = 0; j < 16; ++j) { const unsigned c = xb_ld(&bar[XB_XCNT(j)]); sum += c; cnt += (c > 0u) ? 1u : 0u; mine = (j == x) ? c : mine; }
        if (sum == G) break;
        __builtin_amdgcn_s_sleep(1);
        if ((++sp & 255u) == 0u) { if (xb_ld(&bar[XB_TMO])) break; if (sp > XB_SPIN_CAP) { atomicAdd(&bar[XB_TMO], 1u); break; } }
    }
    nloc = mine > 0u ? mine : 1u; nx = cnt > 0u ? cnt : 1u;
}
__device__ __forceinline__ void xcd_barrier(const XcdBarrier& b) {
    asm volatile("s_waitcnt vmcnt(0)" ::: "memory");
    __syncthreads();
    if (threadIdx.x == 0) {
        unsigned* bar = b.bar;
        __builtin_amdgcn_s_waitcnt(0);
        unsigned nloc = b.st[0], nx = b.st[1];
        if (nloc == 0u) { xcd_barrier_complete(bar, b.x, nloc, nx); b.st[0] = nloc; b.st[1] = nx; }
        const unsigned old = xb_add(&bar[XB_XSUB(b.x)], 1u);
        const unsigned gen = old / nloc;
        if (old + 1u == (gen + 1u) * nloc) {
            __builtin_amdgcn_fence(__ATOMIC_RELEASE, "agent");
            asm volatile("s_waitcnt vmcnt(0)" ::: "memory");
            const unsigned og = xb_add(&bar[XB_TOP], 1u);
            const unsigned tg = og / nx;
            if (og + 1u == (tg + 1u) * nx) xb_add(&bar[XB_TOPGEN], 1u);
            else XB_SPIN(xb_ld(&bar[XB_TOPGEN]) == tg, bar);
            __builtin_amdgcn_fence(__ATOMIC_ACQUIRE, "agent");
            xb_add(&bar[XB_XGEN(b.x)], 1u);
            asm volatile("s_waitcnt vmcnt(0)" ::: "memory");
        } else {
            XB_SPIN(xb_ld(&bar[XB_XGEN(b.x)]) == gen, bar);
            __builtin_amdgcn_fence(__ATOMIC_ACQUIRE, "agent");
            asm volatile("s_waitcnt vmcnt(0)" ::: "memory");
        }
    }
    __syncthreads();
}

namespace pg8 {
constexpr int BM = 256, BK = 64, HALF = 128, HTB = HALF * BK * 2, STAGE_BYTES = 8 * HTB;
__device__ __forceinline__ int lds_byte(int r, int c) { const int st = (r >> 4) * 2 + (c >> 5), rr = r & 15, cc = c & 31, ob = rr * 64 + cc * 2; return st * 1024 + (ob ^ (((ob >> 9) & 1) << 5)); }
__device__ __forceinline__ void stage_rc(int b, int& R, int& C) { const int st = b / 1024, sb = b % 1024, swz = sb ^ (((sb >> 9) & 1) << 5); R = (st >> 1) * 16 + swz / 64; C = (st & 1) * 32 + (swz % 64) / 2; }
__device__ __forceinline__ int perm32(int rho) { const int n = rho >> 4, i = rho & 15; return 8 * (i >> 2) + 4 * n + (i & 3); }
struct Unit { int pm, pn; };
struct Gemm { const bf16* A; const bf16* Bt; int K; const int* rowidx; const bf16* A2; const bf16* Bt2; };

__device__ __forceinline__ void static_unit(int wgid, int nM, int nN, Unit& u) {
    const int nwg = nM * nN;
    { const int q = nwg / 8, r = nwg % 8, xcd = wgid % 8, off = wgid / 8; wgid = (xcd < r ? xcd * (q + 1) : r * (q + 1) + (xcd - r) * q) + off; }
    const int nig = 8 * nN, gid = wgid / nig, fm = gid * 8, gsz = (nM - fm) < 8 ? (nM - fm) : 8;
    u.pm = fm + ((wgid % nig) % gsz); u.pn = (wgid % nig) / gsz;
}
struct StaticOrder { int nM, nN, G, c;
    __device__ __forceinline__ bool next(int i, Unit& u) const { const long L = (long)i * G + c; if (L >= (long)nM * nN) return false; static_unit((int)L, nM, nN, u); return true; } };

__device__ __forceinline__ unsigned cvt_pk_bf16(float lo, float hi) { unsigned r; asm volatile("v_cvt_pk_bf16_f32 %0, %1, %2" : "=v"(r) : "v"(lo), "v"(hi)); return r; }

template <class Epi, class Sched, bool GATHER, bool DUAL = false>
__device__ __forceinline__ void gemm_phase(LAS unsigned char* lds, const Gemm g, const Sched& S, const Epi& E) {
    const int tid = threadIdx.x, wid = __builtin_amdgcn_readfirstlane(tid >> 6), lane = tid & 63, wr = wid >> 2, wc = wid & 3, fr = lane & 15, fq = lane >> 4;
    const int K = g.K, nt = K / BK;
    int sR[2], sC[2]; unsigned voffB[2];
#pragma unroll
    for (int i = 0; i < 2; ++i) { int R, C; stage_rc(tid * 16 + i * 8192, R, C); sR[i] = R; sC[i] = C; const int Rb = Epi::PERM ? ((R & ~31) + perm32(R & 31)) : R; voffB[i] = (unsigned)(Rb * K + C) * 2u; }
    const size_t kstep = (size_t)(BK * 2);
    const size_t hstep = (size_t)HALF * K * 2;
    const size_t tstep = 2 * hstep;
    const unsigned ldsw = (unsigned)wid * 1024u;
    const int aoff = lds_byte(wr * 64 + fr, fq * 8), boff = lds_byte(wc * 32 + fr, fq * 8);
#define PG8_SA(b, h) (((b) * 2 + (h)) * HTB)
#define PG8_SB(b, h) ((4 + (b) * 2 + (h)) * HTB)
#define PG8_STAGE(bufoff, gbase, voff) do { _Pragma("unroll") for (int _i = 0; _i < 2; ++_i) \
        __builtin_amdgcn_global_load_lds((const unsigned*)((const char*)(gbase) + (voff)[_i]), (LAS unsigned*)(lds + (bufoff) + ldsw + _i * 8192), 16, 0, 0); } while (0)
#define PG8_STAGEA(bufoff, ab, kb, ofs) do { _Pragma("unroll") for (int _i = 0; _i < 2; ++_i) \
        __builtin_amdgcn_global_load_lds((const unsigned*)((ab) + (kb) + (ofs)[_i]), (LAS unsigned*)(lds + (bufoff) + ldsw + _i * 8192), 16, 0, 0); } while (0)
#define PG8_LDA(dst, b, h) do { _Pragma("unroll") for (int m = 0; m < 4; ++m) _Pragma("unroll") for (int k = 0; k < 2; ++k) dst[m][k] = *(const LAS bf16x8*)(lds + PG8_SA(b, h) + aoff + m * 2048 + k * 1024); } while (0)
#define PG8_LDB(dst, b, h) do { _Pragma("unroll") for (int n = 0; n < 2; ++n) _Pragma("unroll") for (int k = 0; k < 2; ++k) dst[n][k] = *(const LAS bf16x8*)(lds + PG8_SB(b, h) + boff + n * 2048 + k * 1024); } while (0)
#define PG8_MMA(ai, bj, At, Bt) do { __builtin_amdgcn_s_setprio(1); _Pragma("unroll") for (int m = 0; m < 4; ++m) _Pragma("unroll") for (int n = 0; n < 2; ++n) _Pragma("unroll") for (int k = 0; k < 2; ++k) \
        acc[ai][bj][m][n] = __builtin_amdgcn_mfma_f32_16x16x32_bf16(Bt[n][k], At[m][k], acc[ai][bj][m][n], 0, 0, 0); __builtin_amdgcn_s_setprio(0); } while (0)
#define PG8_WAIT_V(n) asm volatile("s_waitcnt vmcnt(" #n ")" ::: "memory")
#define PG8_WAIT_L(n) asm volatile("s_waitcnt lgkmcnt(" #n ")" ::: "memory")
#define PG8_BAR __builtin_amdgcn_s_barrier()
#define PG8_SCHED __builtin_amdgcn_sched_barrier(0)
#define PG8_ROWOFS(dst, u) do { _Pragma("unroll") for (int _h = 0; _h < 2; ++_h) _Pragma("unroll") for (int _i = 0; _i < 2; ++_i) { \
        const int _r = (u).pm * BM + _h * HALF + sR[_i]; const unsigned _row = GATHER ? (unsigned)g.rowidx[_r] : (unsigned)_r; \
        dst[_h][_i] = (_row * (unsigned)K + (unsigned)sC[_i]) * 2u; } } while (0)
#define PG8_ROWRAW(dst, u) do { _Pragma("unroll") for (int _h = 0; _h < 2; ++_h) _Pragma("unroll") for (int _i = 0; _i < 2; ++_i) \
        dst[_h][_i] = (unsigned)g.rowidx[(u).pm * BM + _h * HALF + sR[_i]]; } while (0)
#define PG8_RAW2OFS(dst, raw) do { _Pragma("unroll") for (int _h = 0; _h < 2; ++_h) _Pragma("unroll") for (int _i = 0; _i < 2; ++_i) \
        dst[_h][_i] = (raw[_h][_i] * (unsigned)K + (unsigned)sC[_i]) * 2u; } while (0)
    Unit cur, nxt; int ui = 0;
    if (!S.next(0, cur)) return;
    f32x4 acc[2][2][4][2];
    f32x4 nb[2][2];
#pragma unroll
    for (int b = 0; b < 2; ++b)
#pragma unroll
        for (int n = 0; n < 2; ++n) nb[b][n] = (f32x4){0.f, 0.f, 0.f, 0.f};
    if constexpr (Epi::HAS_BIAS) E.load_bias(nb, cur, wc, fq);
#pragma unroll
    for (int a = 0; a < 2; ++a)
#pragma unroll
        for (int b = 0; b < 2; ++b)
#pragma unroll
            for (int m = 0; m < 4; ++m)
#pragma unroll
                for (int n = 0; n < 2; ++n) acc[a][b][m][n] = nb[b][n];
    bf16x8 At[4][2], B0[2][2], B1[2][2];
    unsigned cofs[2][2], nofs[2][2];
    PG8_ROWOFS(cofs, cur);
    bool has_next = S.next(1, nxt);
    unsigned nraw[2][2];
    if (GATHER && has_next) PG8_ROWRAW(nraw, nxt);
    const char* cAb = (const char*)((DUAL && (cur.pn >> 16)) ? g.A2 : g.A);
    const char* cB = (const char*)((DUAL && (cur.pn >> 16)) ? g.Bt2 : g.Bt) + (size_t)(cur.pn & 0xffff) * tstep;
    PG8_STAGE(PG8_SB(0, 0), cB, voffB); PG8_STAGE(PG8_SB(0, 1), cB + hstep, voffB); PG8_STAGEA(PG8_SA(0, 0), cAb, 0, cofs[0]); PG8_STAGEA(PG8_SA(0, 1), cAb, 0, cofs[1]);
    if (wr == 1) PG8_BAR;
    PG8_WAIT_V(2); PG8_BAR;
    PG8_STAGE(PG8_SB(1, 0), cB + kstep, voffB); PG8_STAGEA(PG8_SA(1, 0), cAb, kstep, cofs[0]); PG8_STAGE(PG8_SB(1, 1), cB + hstep + kstep, voffB);
    PG8_WAIT_V(6); PG8_BAR;
    for (;;) {
        if (has_next) { if (GATHER) { PG8_RAW2OFS(nofs, nraw); } else { PG8_ROWOFS(nofs, nxt); } }
        else {
#pragma unroll
            for (int h = 0; h < 2; ++h)
#pragma unroll
                for (int i = 0; i < 2; ++i) nofs[h][i] = cofs[h][i];
        }
        Unit n2; const bool has_n2 = has_next && S.next(ui + 2, n2);
        if (GATHER && has_n2) PG8_ROWRAW(nraw, n2);
        const char* nB = has_next ? (const char*)((DUAL && (nxt.pn >> 16)) ? g.Bt2 : g.Bt) + (size_t)(nxt.pn & 0xffff) * tstep : cB;
        const char* nAb = has_next ? (const char*)((DUAL && (nxt.pn >> 16)) ? g.A2 : g.A) : cAb;
        for (int t = 0; t < nt; t += 2) {
            const bool last = (t == nt - 2);
            const size_t k1 = (size_t)(t + 1) * kstep;
            const size_t k2 = last ? 0 : (size_t)(t + 2) * kstep; const size_t k3 = k2 + kstep;
            const char* b2 = last ? nB : cB + (size_t)(t + 2) * kstep; const char* b3 = b2 + kstep;
            const char* ab2 = last ? nAb : cAb;
            unsigned o2[2][2];
#pragma unroll
            for (int h = 0; h < 2; ++h)
#pragma unroll
                for (int i = 0; i < 2; ++i) o2[h][i] = last ? nofs[h][i] : cofs[h][i];
            PG8_LDB(B0, 0, 0); PG8_LDB(B1, 0, 1); PG8_SCHED; PG8_LDA(At, 0, 0); PG8_STAGEA(PG8_SA(1, 1), cAb, k1, cofs[1]);
            PG8_WAIT_V(8); PG8_WAIT_L(0); PG8_BAR; PG8_MMA(0, 0, At, B0); PG8_MMA(0, 1, At, B1); PG8_BAR; PG8_SCHED;
            PG8_LDA(At, 0, 1); PG8_STAGE(PG8_SB(0, 0), b2, voffB); PG8_STAGE(PG8_SB(0, 1), b2 + hstep, voffB); PG8_STAGEA(PG8_SA(0, 0), ab2, k2, o2[0]);
            PG8_WAIT_V(8); PG8_WAIT_L(0); PG8_BAR; PG8_MMA(1, 0, At, B0); PG8_MMA(1, 1, At, B1); PG8_BAR; PG8_SCHED;
            PG8_LDB(B0, 1, 0); PG8_LDB(B1, 1, 1); PG8_SCHED; PG8_LDA(At, 1, 0); PG8_STAGEA(PG8_SA(0, 1), ab2, k2, o2[1]);
            PG8_WAIT_V(8); PG8_WAIT_L(0); PG8_BAR; PG8_MMA(0, 0, At, B0); PG8_MMA(0, 1, At, B1); PG8_BAR; PG8_SCHED;
            PG8_LDA(At, 1, 1); PG8_STAGE(PG8_SB(1, 0), b3, voffB); PG8_STAGE(PG8_SB(1, 1), b3 + hstep, voffB); PG8_STAGEA(PG8_SA(1, 0), ab2, k3, o2[0]);
            PG8_WAIT_V(8); PG8_WAIT_L(0); PG8_BAR; PG8_MMA(1, 0, At, B0); PG8_MMA(1, 1, At, B1); PG8_BAR; PG8_SCHED;
        }
        if (wr == 0) PG8_BAR;
        if constexpr (Epi::HAS_BIAS) { if (has_next) E.load_bias(nb, nxt, wc, fq); }
        E(acc, cur, wr, wc, fr, fq);
        if (!has_next) break;
        if (!DUAL || (cur.pn >> 16)) {
#pragma unroll
        for (int a = 0; a < 2; ++a)
#pragma unroll
            for (int b = 0; b < 2; ++b)
#pragma unroll
                for (int m = 0; m < 4; ++m)
#pragma unroll
                    for (int n = 0; n < 2; ++n) acc[a][b][m][n] = nb[b][n];
        }
        cur = nxt; cB = nB; cAb = nAb; ++ui; nxt = n2; has_next = has_n2;
#pragma unroll
        for (int h = 0; h < 2; ++h)
#pragma unroll
            for (int i = 0; i < 2; ++i) cofs[h][i] = nofs[h][i];
        if (wr == 1) PG8_BAR;
    }
    PG8_WAIT_V(0);
    PG8_BAR;
#undef PG8_SA
#undef PG8_SB
#undef PG8_STAGE
#undef PG8_STAGEA
#undef PG8_LDA
#undef PG8_LDB
#undef PG8_MMA
#undef PG8_WAIT_V
#undef PG8_WAIT_L
#undef PG8_BAR
#undef PG8_SCHED
#undef PG8_ROWOFS
#undef PG8_ROWRAW
#undef PG8_RAW2OFS
}
}
using pg8::Unit;
typedef f32x4 AccT[2][2][4][2];

struct Args { const float* in[25]; float* out; unsigned char* ws; int ph_lo, ph_hi; };
struct Frame { LAS unsigned char* lds; LAS unsigned char* misc; int tid, lane, wave, G, bid; };

#define IN_X 0
#define IN_C 1
#define IN_CTX 2
#define IN_CCTX 3
#define IN_WADA 4
#define IN_BADA 5
#define IN_N1W 6
#define IN_WIN 7
#define IN_GATEB 8
#define IN_CONVW 9
#define IN_CONVB 10
#define IN_WPOOL 11
#define IN_PSCALE 12
#define IN_HNW 13
#define IN_WBP 14
#define IN_WBM 15
#define IN_WOUT 16
#define IN_N2W 17
#define IN_WR 18
#define IN_BR 19
#define IN_W1 20
#define IN_B1 21
#define IN_W2 22
#define IN_B2 23
#define IN_FNW 24

__device__ __forceinline__ bf16* x1_row(float* out, unsigned char* ws, int t) { return t < XSPLIT ? (bf16*)out + (size_t)T * D + (size_t)t * D : (bf16*)(ws + WS_X1B) + (size_t)(t - XSPLIT) * D; }
template <class RowMap>
__device__ __forceinline__ void tr_item(const float* W, int K, int N, bf16* WT, LAS float* scr, int item, int lane, const RowMap& rowmap) {
    const int nblk = (N + 31) / 32, kb = item / nblk, nb = item % nblk, k0 = 64 * kb, n0 = 32 * nb;
    const int nn = n0 + (lane & 31);
#pragma unroll
    for (int i = 0; i < 32; ++i) { const int kk = 2 * i + (lane >> 5); scr[kk * 33 + (lane & 31)] = (nn < N) ? W[(size_t)(k0 + kk) * N + nn] : 0.f; }
    LDS_WAIT(); asm volatile("" ::: "memory");
    const int c = lane & 7;
#pragma unroll
    for (int j = 0; j < 4; ++j) { const int n = (lane >> 3) + 8 * j; const LAS float* s = scr + (8 * c) * 33 + n;
        u32x4 o; o.x = pk2(s[0 * 33], s[1 * 33]); o.y = pk2(s[2 * 33], s[3 * 33]); o.z = pk2(s[4 * 33], s[5 * 33]); o.w = pk2(s[6 * 33], s[7 * 33]);
        if (n0 + n < N) *(u32x4*)(WT + (size_t)rowmap(n0 + n) * K + k0 + 8 * c) = o; }
    LDS_WAIT(); asm volatile("" ::: "memory");
}
struct MapId { int off; __device__ __forceinline__ int operator()(int n) const { return off + n; } };
struct MapWin { __device__ __forceinline__ int operator()(int c) const { return c < 2560 ? c : (c < 2576 ? 4608 + (c - 2560) : c - 16); } };
struct MapW1 { int off; __device__ __forceinline__ int operator()(int n) const { const int up = n >= 1024, nn = n & 1023; return off + (nn >> 7) * 256 + up * 128 + (nn & 127); } };

__device__ __forceinline__ void p0_prologue(const Args& a, const Frame& F) {
    LAS float* scr = (LAS float*)(F.lds + F.wave * 8448);
    LAS float* sc = (LAS float*)(F.lds + 69632);
    LAS float* red = (LAS float*)(F.lds + 106496);
    unsigned char* ws = a.ws;
    for (int item = F.bid; item < 96; item += F.G) {
        __syncthreads();
        for (int i = F.tid; i < 9 * 1024; i += 512) { const int r = i >> 10, k = i & 1023; const float v = (r < 8) ? a.in[IN_C][r * 1024 + k] : a.in[IN_CCTX][k]; sc[i] = v * sigmoidf_(v); }
        __syncthreads();
        const int col = 64 * item + F.lane, k0 = F.wave * 128; const float* W = a.in[IN_WADA] + col;
        float acc[9];
#pragma unroll
        for (int q = 0; q < 9; ++q) acc[q] = 0.f;
        for (int kk = 0; kk < 128; kk += 8) {
            float wv[8];
#pragma unroll
            for (int u = 0; u < 8; ++u) wv[u] = W[(size_t)(k0 + kk + u) * 6144];
#pragma unroll
            for (int q = 0; q < 9; ++q) { const f32x4 s0 = *(const LAS f32x4*)(sc + q * 1024 + k0 + kk), s1 = *(const LAS f32x4*)(sc + q * 1024 + k0 + kk + 4);
                acc[q] += (s0.x * wv[0] + s0.y * wv[1]) + (s0.z * wv[2] + s0.w * wv[3]) + (s1.x * wv[4] + s1.y * wv[5]) + (s1.z * wv[6] + s1.w * wv[7]); }
        }
#pragma unroll
        for (int q = 0; q < 9; ++q) red[(F.wave * 9 + q) * 64 + F.lane] = acc[q];
        __syncthreads();
        for (int i = F.tid; i < 9 * 64; i += 512) { const int q = i >> 6, l = i & 63; float s = 0.f;
#pragma unroll
            for (int w8 = 0; w8 < 8; ++w8) s += red[(w8 * 9 + q) * 64 + l];
            ((float*)(ws + WS_MOD))[q * 6144 + 64 * item + l] = s + a.in[IN_BADA][64 * item + l]; }
    }
    __syncthreads();
    const int gw = F.bid * 8 + F.wave, NGW = F.G * 8;
    constexpr int I_WPA = 1024, I_WRT = 32, I_WGT = 16, I_WIN = 16 * 145, I_WBM = 8 * 32, I_WOUT = 16 * 32;
    constexpr int NITEMS = I_WPA + I_WRT + I_WGT + I_WIN + I_WBM + I_WOUT;
    for (int it = gw; it < NITEMS; it += NGW) {
        int r = it;
        if (r < I_WPA) {
            const int g = r >> 8, cb = (r >> 4) & 15, n = (r & 15) * 64 + F.lane, k0 = g * 128 + cb * 8;
            const float* wp = a.in[IN_WPOOL] + (size_t)k0 * 128; const float* ps = a.in[IN_PSCALE] + g * 128; const float* wb = a.in[IN_WBP] + (size_t)(g * 128) * 1024 + n;
            float acc[8];
#pragma unroll
            for (int cc = 0; cc < 8; ++cc) acc[cc] = 0.f;
#pragma unroll 4
            for (int d = 0; d < 128; ++d) { const float wbv = wb[(size_t)d * 1024] * ps[d];
#pragma unroll
                for (int cc = 0; cc < 8; ++cc) acc[cc] += wp[cc * 128 + d] * wbv; }
            u32x4 o; o.x = pk2(acc[0], acc[1]); o.y = pk2(acc[2], acc[3]); o.z = pk2(acc[4], acc[5]); o.w = pk2(acc[6], acc[7]);
            *(u32x4*)((bf16*)(ws + WS_WPA_T) + (size_t)n * 512 + k0) = o;
            continue;
        }
        r -= I_WPA;
        if (r < I_WRT + I_WGT) {
            const bool isr = r < I_WRT; const int e = isr ? r : r - I_WRT; bf16* dst = (bf16*)(ws + (isr ? WS_WR_T : WS_WG_T)); const int nrow = isr ? 32 : 16;
#pragma unroll 4
            for (int i = 0; i < 16; ++i) { const int k = F.lane + 64 * i; const float v = isr ? a.in[IN_WR][k * 32 + e] : a.in[IN_WIN][(size_t)k * INW + 2560 + e];
                const unsigned hi = f2bf(v); const float rem = v - __uint_as_float(hi << 16);
                dst[e * 1024 + k] = (bf16)hi; dst[(nrow + e) * 1024 + k] = (bf16)f2bf(rem); }
            continue;
        }
        r -= I_WRT + I_WGT;
        if (r < I_WIN) { tr_item(a.in[IN_WIN], 1024, INW, (bf16*)(ws + WS_WIN_T), scr, r, F.lane, MapWin{}); continue; } r -= I_WIN;
        if (r < I_WBM) { tr_item(a.in[IN_WBM], 512, 1024, (bf16*)(ws + WS_WBM_T), scr, r, F.lane, MapId{0}); continue; } r -= I_WBM;
        tr_item(a.in[IN_WOUT], 1024, 1024, (bf16*)(ws + WS_WOUT_T), scr, r, F.lane, MapId{0});
    }
}

template <int NT, bool XBF16>
__device__ __forceinline__ void norm_pair(const void* xrow, const LAS float* nwsL, const LAS float* shL, bf16* orow, const LAS unsigned char* Whi, const LAS unsigned char* Wlo,
                                          LAS float* red, int wave, int c, int q, f32x4 (&acc)[NT]) {
    const int hf = wave & 1;
    f32x4 xa[16], xb[16];
    if (XBF16) {
        const u32x4* xp = (const u32x4*)xrow + 64 * hf + q;
        u32x4 xr[16];
#pragma unroll
        for (int j = 0; j < 16; ++j) xr[j] = xp[j * 4];
#pragma unroll
        for (int j = 0; j < 16; ++j) { xa[j] = (f32x4){bflo(xr[j].x), bfhi(xr[j].x), bflo(xr[j].y), bfhi(xr[j].y)}; xb[j] = (f32x4){bflo(xr[j].z), bfhi(xr[j].z), bflo(xr[j].w), bfhi(xr[j].w)}; }
    } else {
        const f32x4* xp = (const f32x4*)xrow + 128 * hf + 2 * q;
#pragma unroll
        for (int j = 0; j < 16; ++j) { xa[j] = xp[j * 8]; xb[j] = xp[j * 8 + 1]; }
    }
    float ss = 0.f;
#pragma unroll
    for (int j = 0; j < 16; ++j) ss += ((xa[j].x * xa[j].x + xa[j].y * xa[j].y) + (xa[j].z * xa[j].z + xa[j].w * xa[j].w)) + ((xb[j].x * xb[j].x + xb[j].y * xb[j].y) + (xb[j].z * xb[j].z + xb[j].w * xb[j].w));
    ss += __shfl_xor(ss, 16); ss += __shfl_xor(ss, 32);
    if (q == 0) red[wave * 16 + c] = ss;
    LDS_BARRIER();
    const float rstd = rsqrtf((red[wave * 16 + c] + red[(wave ^ 1) * 16 + c]) * (1.f / 1024.f) + EPS);
    const LAS f32x4* np = (const LAS f32x4*)nwsL + 128 * hf + 2 * q; const LAS f32x4* hp = (const LAS f32x4*)shL + 128 * hf + 2 * q;
    u32x4* op = (u32x4*)orow + 64 * hf + q;
#pragma unroll
    for (int j = 0; j < 16; ++j) {
        const f32x4 y0 = (xa[j] * rstd) * np[j * 8] + hp[j * 8], y1 = (xb[j] * rstd) * np[j * 8 + 1] + hp[j * 8 + 1];
        u32x4 hi; hi.x = pg8::cvt_pk_bf16(y0.x, y0.y); hi.y = pg8::cvt_pk_bf16(y0.z, y0.w); hi.z = pg8::cvt_pk_bf16(y1.x, y1.y); hi.w = pg8::cvt_pk_bf16(y1.z, y1.w);
        op[j * 4] = hi;
        u32x4 lo; lo.x = pg8::cvt_pk_bf16(y0.x - bflo(hi.x), y0.y - bfhi(hi.x)); lo.y = pg8::cvt_pk_bf16(y0.z - bflo(hi.y), y0.w - bfhi(hi.y));
        lo.z = pg8::cvt_pk_bf16(y1.x - bflo(hi.z), y1.y - bfhi(hi.z)); lo.w = pg8::cvt_pk_bf16(y1.z - bflo(hi.w), y1.w - bfhi(hi.w));
        const bf16x8 ah = __builtin_bit_cast(bf16x8, hi), al = __builtin_bit_cast(bf16x8, lo);
        const int wo = (((4 * (16 * hf + j) + q) ^ c) << 4);
#pragma unroll
        for (int nt = 0; nt < NT; ++nt) { const bf16x8 bh = *(const LAS bf16x8*)(Whi + (16 * nt + c) * 2048 + wo), bl = *(const LAS bf16x8*)(Wlo + (16 * nt + c) * 2048 + wo);
            acc[nt] = __builtin_amdgcn_mfma_f32_16x16x32_bf16(ah, bh, acc[nt], 0, 0, 0); acc[nt] = __builtin_amdgcn_mfma_f32_16x16x32_bf16(al, bh, acc[nt], 0, 0, 0); acc[nt] = __builtin_amdgcn_mfma_f32_16x16x32_bf16(ah, bl, acc[nt], 0, 0, 0); }
    }
}
__device__ __forceinline__ void p1_xn(const Args& a, const Frame& F) {
    LAS unsigned char* Whi = F.lds; LAS unsigned char* Wlo = F.lds + 32768;
    LAS float* NWS = (LAS float*)(F.lds + 65536); LAS float* SHV = (LAS float*)(F.lds + 65536 + 8192);
    LAS float* red = (LAS float*)(F.lds + 81920);
    LAS f32x4* accb = (LAS f32x4*)(F.lds + 82432);
    const bf16* wg = (const bf16*)(a.ws + WS_WG_T);
    const float* mod = (const float*)(a.ws + WS_MOD);
    const int c = F.lane & 15, q = F.lane >> 4, pair = F.wave >> 1;
    bf16* XN = (bf16*)(a.ws + WS_XN); float* GT = (float*)(a.ws + WS_GATES);
    for (int blk = F.bid; blk < 256; blk += F.G) {
        const int mrb = blk >> 5;
        __syncthreads();
        for (int i = F.tid; i < 2 * 16 * 128; i += 512) { const int part = i >> 11, r = (i >> 7) & 15, c16 = i & 127;
            *(LAS u32x4*)((part ? Wlo : Whi) + r * 2048 + ((c16 ^ r) << 4)) = *(const u32x4*)(wg + (size_t)part * 16384 + r * 1024 + c16 * 8); }
        for (int i = F.tid; i < 2 * 1024; i += 512) { const int mr = (i >> 10) ? 8 : mrb, k = i & 1023; NWS[i] = a.in[IN_N1W][k] * (1.0f + mod[mr * 6144 + 1024 + k]); SHV[i] = mod[mr * 6144 + k]; }
        __syncthreads();
        const int nstep = (blk < 32) ? 5 : 4;
        for (int st = 0; st < nstep; ++st) {
            const bool isctx = st == 4;
            const int tile = isctx ? (T / 16 + blk * 4 + pair) : (blk * 16 + st * 4 + pair);
            const int r = tile * 16 + c;
            const float* src = isctx ? a.in[IN_CTX] + (size_t)(r - T) * D : a.in[IN_X] + (size_t)r * D;
            f32x4 acc[1]; acc[0] = (f32x4){0.f, 0.f, 0.f, 0.f};
            norm_pair<1, false>(src, NWS + (isctx ? 1024 : 0), SHV + (isctx ? 1024 : 0), XN + (size_t)r * D, Whi, Wlo, red, F.wave, c, q, acc);
            if (F.wave & 1) accb[pair * 64 + F.lane] = acc[0];
            LDS_BARRIER();
            if (!(F.wave & 1)) { const f32x4 o = acc[0] + accb[pair * 64 + F.lane];
#pragma unroll
                for (int j = 0; j < 4; ++j) GT[(size_t)(tile * 16 + 4 * q + j) * 16 + c] = o[j]; }
        }
    }
}

struct SchedIn { int G, c;
    __device__ __forceinline__ bool next(int i, Unit& u) const {
        long L = (long)i * G + c;
        if (L < 256 * 18) { pg8::static_unit((int)L, 256, 18, u); return true; }
        L -= 256 * 18; if (L >= 48) return false;
        u.pm = 256 + (int)(L / 6); u.pn = 2 + (int)(L % 6); return true; } };
struct EpiIn { static constexpr bool PERM = true, HAS_BIAS = false;
    bf16 *ppool, *pqk, *pv, *po, *pmerge;
    __device__ __forceinline__ void operator()(AccT& acc, const Unit& u, int wr, int wc, int fr, int fq) const {
        const int row0 = u.pm * 256 + wr * 64 + fr, pn = u.pn;
        if (pn < 18) {
            bf16* base; int ld, colt;
            if (pn < 2) { base = ppool; ld = 512; colt = 256 * pn; } else if (pn < 6) { base = pqk; ld = 1024; colt = 256 * (pn - 2); }
            else if (pn < 8) { base = pv; ld = 512; colt = 256 * (pn - 6); } else if (pn < 10) { base = po; ld = 512; colt = 256 * (pn - 8); }
            else { base = pmerge; ld = 2048; colt = 256 * (pn - 10); }
            const int col0 = colt + wc * 32 + 8 * fq;
#pragma unroll
            for (int ai = 0; ai < 2; ++ai)
#pragma unroll
                for (int m = 0; m < 4; ++m) { bf16* rowp = base + (size_t)(row0 + ai * 128 + m * 16) * ld + col0;
#pragma unroll
                    for (int bj = 0; bj < 2; ++bj) { const f32x4 v0 = acc[ai][bj][m][0], v1 = acc[ai][bj][m][1];
                        u32x4 w; w.x = pg8::cvt_pk_bf16(v0[0], v0[1]); w.y = pg8::cvt_pk_bf16(v0[2], v0[3]); w.z = pg8::cvt_pk_bf16(v1[0], v1[1]); w.w = pg8::cvt_pk_bf16(v1[2], v1[3]);
                        *(u32x4*)(rowp + bj * 128) = w; } }
        }
    } };
struct SchedMerge { int G, c;
    __device__ __forceinline__ bool next(int i, Unit& u) const { const long L = (long)(i >> 1) * G + c; if (L >= 1024) return false; pg8::static_unit((int)L, 256, 4, u); u.pn |= (i & 1) << 16; return true; } };
struct EpiMerge { static constexpr bool PERM = true, HAS_BIAS = false;
    const bf16* pmerge; bf16* Y;
    __device__ __forceinline__ void operator()(AccT& acc, const Unit& u, int wr, int wc, int fr, int fq) const {
        const int sel = u.pn >> 16, pn = u.pn & 0xffff;
        const int row0 = u.pm * 256 + wr * 64 + fr, col0 = pn * 256 + wc * 32 + 8 * fq;
#define RAT(aw, bw) ((1.0f + fexp_(-(bw))) * frcp_(1.0f + fexp_(-(aw))))
        if (sel == 0) {
#pragma unroll
            for (int ai = 0; ai < 2; ++ai) {
                u32x4 ga[4][2], gb[4][2];
#pragma unroll
                for (int m = 0; m < 4; ++m)
#pragma unroll
                    for (int bj = 0; bj < 2; ++bj) { const bf16* p = pmerge + (size_t)(row0 + ai * 128 + m * 16) * 2048 + col0 + bj * 128; ga[m][bj] = *(const u32x4*)p; gb[m][bj] = *(const u32x4*)(p + 1024); }
#pragma unroll
                for (int m = 0; m < 4; ++m)
#pragma unroll
                    for (int bj = 0; bj < 2; ++bj) { f32x4& v0 = acc[ai][bj][m][0]; f32x4& v1 = acc[ai][bj][m][1]; const u32x4 a4 = ga[m][bj], b4 = gb[m][bj];
                        v0[0] *= RAT(bflo(a4.x), bflo(b4.x)); v0[1] *= RAT(bfhi(a4.x), bfhi(b4.x)); v0[2] *= RAT(bflo(a4.y), bflo(b4.y)); v0[3] *= RAT(bfhi(a4.y), bfhi(b4.y));
                        v1[0] *= RAT(bflo(a4.z), bflo(b4.z)); v1[1] *= RAT(bfhi(a4.z), bfhi(b4.z)); v1[2] *= RAT(bflo(a4.w), bflo(b4.w)); v1[3] *= RAT(bfhi(a4.w), bfhi(b4.w)); }
                asm volatile("" ::: "memory");
            }
        } else {
            u32x4 gb[2][4][2];
#pragma unroll
            for (int ai = 0; ai < 2; ++ai)
#pragma unroll
                for (int m = 0; m < 4; ++m)
#pragma unroll
                    for (int bj = 0; bj < 2; ++bj) gb[ai][m][bj] = *(const u32x4*)(pmerge + (size_t)(row0 + ai * 128 + m * 16) * 2048 + 1024 + col0 + bj * 128);
#pragma unroll
            for (int ai = 0; ai < 2; ++ai)
#pragma unroll
                for (int m = 0; m < 4; ++m)
#pragma unroll
                    for (int bj = 0; bj < 2; ++bj) { const f32x4 v0 = acc[ai][bj][m][0], v1 = acc[ai][bj][m][1]; const u32x4 b4 = gb[ai][m][bj];
                        u32x4 w; w.x = pg8::cvt_pk_bf16(sigmoidf_(bflo(b4.x)) * v0[0], sigmoidf_(bfhi(b4.x)) * v0[1]); w.y = pg8::cvt_pk_bf16(sigmoidf_(bflo(b4.y)) * v0[2], sigmoidf_(bfhi(b4.y)) * v0[3]);
                        w.z = pg8::cvt_pk_bf16(sigmoidf_(bflo(b4.z)) * v1[0], sigmoidf_(bfhi(b4.z)) * v1[1]); w.w = pg8::cvt_pk_bf16(sigmoidf_(bflo(b4.w)) * v1[2], sigmoidf_(bfhi(b4.w)) * v1[3]);
                        *(u32x4*)(Y + (size_t)(row0 + ai * 128 + m * 16) * 1024 + col0 + bj * 128) = w; }
        }
#undef RAT
    } };
struct EpiOut { static constexpr bool PERM = true, HAS_BIAS = false;
    const float* x; const float* mod; float* out; unsigned char* ws;
    __device__ __forceinline__ void operator()(AccT& acc, const Unit& u, int wr, int wc, int fr, int fq) const {
        const int row0 = u.pm * 256 + wr * 64 + fr, col0 = u.pn * 256 + wc * 32 + 8 * fq;
        const float* g1 = mod + (u.pm >> 5) * 6144 + 2048 + col0;
        f32x4 gv[2][2];
#pragma unroll
        for (int bj = 0; bj < 2; ++bj)
#pragma unroll
            for (int n = 0; n < 2; ++n) gv[bj][n] = *(const f32x4*)(g1 + bj * 128 + n * 4);
        bf16* x1b = x1_row(out, ws, u.pm * 256);
#pragma unroll
        for (int ai = 0; ai < 2; ++ai) {
            f32x4 xv[4][2][2];
#pragma unroll
            for (int m = 0; m < 4; ++m)
#pragma unroll
                for (int bj = 0; bj < 2; ++bj)
#pragma unroll
                    for (int n = 0; n < 2; ++n) xv[m][bj][n] = *(const f32x4*)(x + (size_t)(row0 + ai * 128 + m * 16) * 1024 + col0 + bj * 128 + n * 4);
#pragma unroll
            for (int m = 0; m < 4; ++m)
#pragma unroll
                for (int bj = 0; bj < 2; ++bj) { const f32x4 v0 = xv[m][bj][0] + gv[bj][0] * acc[ai][bj][m][0], v1 = xv[m][bj][1] + gv[bj][1] * acc[ai][bj][m][1];
                    u32x4 w; w.x = pg8::cvt_pk_bf16(v0[0], v0[1]); w.y = pg8::cvt_pk_bf16(v0[2], v0[3]); w.z = pg8::cvt_pk_bf16(v1[0], v1[1]); w.w = pg8::cvt_pk_bf16(v1[2], v1[3]);
                    *(u32x4*)(x1b + (size_t)(wr * 64 + fr + ai * 128 + m * 16) * 1024 + col0 + bj * 128) = w; }
            asm volatile("" ::: "memory");
        }
    } };
struct SchedMoe { int G, c, NT, tlo, thi; const LAS unsigned char* tile_g;
    __device__ __forceinline__ bool next(int i, Unit& u) const {
        int tile, pnl;
        if (G == 256) { const int x = c & 7, j = c >> 3, tpx = 32 / NT; tile = tlo + i * (8 * tpx) + x * tpx + j / NT; pnl = j % NT; }
        else { const long L = (long)i * G + c; tile = tlo + (int)(L / NT); pnl = (int)(L % NT); }
        if (tile >= thi) return false;
        const int e = tile_g[tile] & 31; u.pm = tile; u.pn = e * NT + pnl; return true; } };
struct EpiMoe1 { static constexpr bool PERM = true, HAS_BIAS = true;
    const float* b1; bf16* act;
    __device__ __forceinline__ void load_bias(f32x4 (&nb)[2][2], const Unit& u, int wc, int fq) const {
        const int e = u.pn >> 3, pnl = u.pn & 7; const float* bg = b1 + (size_t)e * 2048 + pnl * 128 + wc * 32 + 8 * fq;
        nb[0][0] = *(const f32x4*)bg; nb[0][1] = *(const f32x4*)(bg + 4); nb[1][0] = *(const f32x4*)(bg + 1024); nb[1][1] = *(const f32x4*)(bg + 1028); }
    __device__ __forceinline__ void operator()(AccT& acc, const Unit& u, int wr, int wc, int fr, int fq) const {
        const int pnl = u.pn & 7, row0 = u.pm * 256 + wr * 64 + fr, jc = pnl * 128 + wc * 32 + 8 * fq;
#pragma unroll
        for (int ai = 0; ai < 2; ++ai)
#pragma unroll
            for (int m = 0; m < 4; ++m) {
                const f32x4 g0 = acc[ai][0][m][0], g1 = acc[ai][0][m][1], u0 = acc[ai][1][m][0], u1 = acc[ai][1][m][1];
                float r[8];
#pragma unroll
                for (int h2 = 0; h2 < 4; ++h2) { const f32x4& gs = (h2 < 2) ? g0 : g1; const f32x4& us = (h2 < 2) ? u0 : u1; const int j0 = (h2 & 1) * 2;
                    f32x2 gv2 = (f32x2){fminf(gs[j0], 7.0f), fminf(gs[j0 + 1], 7.0f)};
                    f32x2 uv2 = (f32x2){__builtin_amdgcn_fmed3f(us[j0], -7.0f, 7.0f), __builtin_amdgcn_fmed3f(us[j0 + 1], -7.0f, 7.0f)};
                    const f32x2 t2 = gv2 * -2.4554669595930157f;
                    f32x2 e2; e2.x = __builtin_amdgcn_exp2f(t2.x); e2.y = __builtin_amdgcn_exp2f(t2.y);
                    const f32x2 d2 = e2 + 1.0f;
                    f32x2 s2; s2.x = frcp_(d2.x); s2.y = frcp_(d2.y);
                    const f32x2 o2 = ((uv2 + 1.0f) * gv2) * s2;
                    r[h2 * 2] = o2.x; r[h2 * 2 + 1] = o2.y; }
                u32x4 w; w.x = pg8::cvt_pk_bf16(r[0], r[1]); w.y = pg8::cvt_pk_bf16(r[2], r[3]); w.z = pg8::cvt_pk_bf16(r[4], r[5]); w.w = pg8::cvt_pk_bf16(r[6], r[7]);
                *(u32x4*)(act + (size_t)(row0 + ai * 128 + m * 16) * 1024 + jc) = w; }
    } };
struct EpiMoe2 { static constexpr bool PERM = true, HAS_BIAS = true;
    const float* b2; bf16* outk; int rowbase;
    __device__ __forceinline__ void load_bias(f32x4 (&nb)[2][2], const Unit& u, int wc, int fq) const {
        const int e = u.pn >> 2, pnl = u.pn & 3; const float* bp = b2 + (size_t)e * 1024 + pnl * 256 + wc * 32 + 8 * fq;
#pragma unroll
        for (int bj = 0; bj < 2; ++bj) { nb[bj][0] = *(const f32x4*)(bp + bj * 128); nb[bj][1] = *(const f32x4*)(bp + bj * 128 + 4); } }
    __device__ __forceinline__ void operator()(AccT& acc, const Unit& u, int wr, int wc, int fr, int fq) const {
        const int pnl = u.pn & 3, row0 = u.pm * 256 - rowbase + wr * 64 + fr, col0 = pnl * 256 + wc * 32 + 8 * fq;
#pragma unroll
        for (int ai = 0; ai < 2; ++ai)
#pragma unroll
            for (int m = 0; m < 4; ++m) { bf16* rowp = outk + (size_t)(row0 + ai * 128 + m * 16) * 1024 + col0;
#pragma unroll
                for (int bj = 0; bj < 2; ++bj) { const f32x4 v0 = acc[ai][bj][m][0], v1 = acc[ai][bj][m][1];
                    u32x4 o; o.x = pg8::cvt_pk_bf16(v0[0], v0[1]); o.y = pg8::cvt_pk_bf16(v0[2], v0[3]); o.z = pg8::cvt_pk_bf16(v1[0], v1[1]); o.w = pg8::cvt_pk_bf16(v1[2], v1[3]);
                    *(u32x4*)(rowp + bj * 128) = o; } }
    } };

__device__ __forceinline__ void p3_conv(const Args& a, const Frame& F) {
    const bf16* PQK = (const bf16*)(a.ws + WS_PQK); bf16* QKC = (bf16*)(a.ws + WS_QKC);
    const float* cw = a.in[IN_CONVW]; const float* cb = a.in[IN_CONVB];
    const int cg = F.tid & 127, sub = F.tid >> 7, c0 = cg * 8;
    float w0[8], w1[8], w2[8], bb[8];
#pragma unroll
    for (int j = 0; j < 8; ++j) { w0[j] = cw[c0 + j]; w1[j] = cw[1024 + c0 + j]; w2[j] = cw[2048 + c0 + j]; bb[j] = cb[c0 + j]; }
    const float scl = c0 < 512 ? 0.08838834764831845f : 1.0f;
    const u32x4 z = (u32x4){0u, 0u, 0u, 0u};
    for (int item = F.bid * 4 + sub; item < TA / 16; item += F.G * 4) {
        const int r0 = item * 16;
        const int len = (r0 < T) ? SEQ : CTXL, pos0 = (r0 < T) ? (r0 & (SEQ - 1)) : ((r0 - T) & (CTXL - 1));
        u32x4 rw[18];
#pragma unroll
        for (int i = 0; i < 18; ++i) { const int pos = pos0 + i - 1; rw[i] = (pos >= 0 && pos < len) ? *(const u32x4*)(PQK + (size_t)(r0 + i - 1) * 1024 + c0) : z; }
#pragma unroll
        for (int i = 0; i < 16; ++i) {
            const unsigned wm[4] = {rw[i].x, rw[i].y, rw[i].z, rw[i].w}, wc_[4] = {rw[i + 1].x, rw[i + 1].y, rw[i + 1].z, rw[i + 1].w}, wp[4] = {rw[i + 2].x, rw[i + 2].y, rw[i + 2].z, rw[i + 2].w};
            float o[8];
#pragma unroll
            for (int j = 0; j < 4; ++j) {
                const float a0 = bb[2 * j] + bflo(wm[j]) * w0[2 * j] + bflo(wc_[j]) * w1[2 * j] + bflo(wp[j]) * w2[2 * j];
                const float a1 = bb[2 * j + 1] + bfhi(wm[j]) * w0[2 * j + 1] + bfhi(wc_[j]) * w1[2 * j + 1] + bfhi(wp[j]) * w2[2 * j + 1];
                o[2 * j] = a0 * sigmoidf_(a0) * scl; o[2 * j + 1] = a1 * sigmoidf_(a1) * scl; }
            u32x4 w; w.x = pk2(o[0], o[1]); w.y = pk2(o[2], o[3]); w.z = pk2(o[4], o[5]); w.w = pk2(o[6], o[7]);
            *(u32x4*)(QKC + (size_t)(r0 + i) * 1024 + c0) = w;
        }
    }
    {
        const float* GT = (const float*)(a.ws + WS_GATES); float* GS = (float*)(a.ws + WS_GS); float* CH = (float*)(a.ws + WS_CHK);
        const int gw = F.bid * 8 + F.wave, NGW = F.G * 8, lane = F.lane;
        for (int it = gw; it < (TA / 128) * 8; it += NGW) {
            const int chunk = it >> 3, hd = it & 7, dir = hd >> 2, h = hd & 3, c0r = chunk * 128, t0 = 2 * lane;
            const int r0 = c0r + (dir ? 127 - t0 : t0), r1 = c0r + (dir ? 126 - t0 : t0 + 1);
            const int gi = (dir ? 8 : 0) + h, gf = (dir ? 12 : 4) + h; const float gbi = a.in[IN_GATEB][gi], gbf = a.in[IN_GATEB][gf];
            const float i0 = GT[(size_t)r0 * 16 + gi] + gbi, i1 = GT[(size_t)r1 * 16 + gi] + gbi, f0 = GT[(size_t)r0 * 16 + gf] + gbf, f1 = GT[(size_t)r1 * 16 + gf] + gbf;
            const float l0 = fminf(f0, 0.f) - __logf(1.0f + __expf(-fabsf(f0))), l1 = fminf(f1, 0.f) - __logf(1.0f + __expf(-fabsf(f1)));
            const float p1 = l0 + l1; float inc = p1;
#pragma unroll
            for (int o = 1; o < 64; o <<= 1) { const float t = __shfl_up(inc, o); if (lane >= o) inc += t; }
            const float exc = inc - p1, b0 = exc + l0, b1 = inc;
            const float g0 = i0 - b0, g1 = i1 - b1; float im = fmaxf(g0, g1);
#pragma unroll
            for (int o = 1; o < 64; o <<= 1) { const float t = __shfl_up(im, o); if (lane >= o) im = fmaxf(im, t); }
            float em = __shfl_up(im, 1); if (lane == 0) em = -INFINITY;
            GS[(size_t)hd * TA + r0] = g0; GS[(size_t)hd * TA + r1] = g1;
            GS[(size_t)(8 + hd) * TA + r0] = fmaxf(em, g0); GS[(size_t)(8 + hd) * TA + r1] = im;
            GS[(size_t)(16 + hd) * TA + r0] = b0; GS[(size_t)(16 + hd) * TA + r1] = b1;
            if (lane == 63) { CH[(hd * 528 + chunk) * 2] = inc; CH[(hd * 528 + chunk) * 2 + 1] = im; }
            { float tm = fmaxf(g0, g1);
#pragma unroll
              for (int o = 1; o < 8; o <<= 1) tm = fmaxf(tm, __shfl_xor(tm, o));
              if ((lane & 7) == 0) ((float*)(a.ws + WS_GTILE))[(hd * 528 + chunk) * 8 + (lane >> 3)] = tm; }
        }
    }
}

constexpr int SP = 272;
constexpr int S_QS = 0, S_K0 = 34816, S_K1 = 69632, S_VT = 104448, S_VA0 = 113424, S_VA1 = 122400, S_CT = 131376, S_GL = 144432, S_PM = 144944, S_BL = 145456;
__device__ __forceinline__ unsigned off_b(unsigned row, unsigned ch) { return 256u * row + 16u * (ch ^ (((row & 3u) << 2) | ((row >> 2) & 3u))); }
__device__ __forceinline__ bf16x8 mk_frag(u32x2 lo, u32x2 hi) { u32x4 v; v.x = lo.x; v.y = lo.y; v.z = hi.x; v.w = hi.y; return __builtin_bit_cast(bf16x8, v); }
__device__ __forceinline__ void tr_read_k8(u32x2 (&r)[8], const unsigned (&ad)[8]) {
    asm volatile(
        "ds_read_b64_tr_b16 %0, %8\n\tds_read_b64_tr_b16 %1, %9\n\tds_read_b64_tr_b16 %2, %10\n\tds_read_b64_tr_b16 %3, %11\n\t"
        "ds_read_b64_tr_b16 %4, %12\n\tds_read_b64_tr_b16 %5, %13\n\tds_read_b64_tr_b16 %6, %14\n\tds_read_b64_tr_b16 %7, %15\n\t"
        "s_waitcnt lgkmcnt(0)"
        : "=&v"(r[0]), "=&v"(r[1]), "=&v"(r[2]), "=&v"(r[3]), "=&v"(r[4]), "=&v"(r[5]), "=&v"(r[6]), "=&v"(r[7])
        : "v"(ad[0]), "v"(ad[1]), "v"(ad[2]), "v"(ad[3]), "v"(ad[4]), "v"(ad[5]), "v"(ad[6]), "v"(ad[7]) : "memory");
}
__device__ __forceinline__ void p4_scan(const Args& a, const Frame& F) {
    LAS unsigned char* L = F.lds;
    const bf16* QKC = (const bf16*)(a.ws + WS_QKC); const bf16* PV = (const bf16*)(a.ws + WS_PV);
    const float* GS = (const float*)(a.ws + WS_GS); const float* CH = (const float*)(a.ws + WS_CHK);
    const int tid = F.tid, lane = F.lane, w = F.wave, c = lane & 15, q = lane >> 4;
    LAS float* GL = (LAS float*)(L + S_GL); LAS float* PML = (LAS float*)(L + S_PM); LAS float* BL = (LAS float*)(L + S_BL);
    const unsigned Lb = (unsigned)(size_t)L;
    for (int blk = F.bid; blk < 256; blk += F.G) {
        const int xx = blk & 7, yy = blk >> 3, sub = yy & 7, bh = xx * 4 + (yy >> 3);
        const int vs = sub & 3, dir = sub >> 2, h = bh & 3, b = bh >> 2, hd = dir * 4 + h;
        bf16* HX = (bf16*)(a.ws + (dir ? WS_HB : WS_HF));
        __syncthreads();
        for (int i = tid; i < 128; i += 512) *(LAS bf16*)(L + S_VT + 32 * SP + i * 2) = (bf16)0x3F80;
        for (int i = tid; i < 48 * 136; i += 512) *(LAS bf16*)(L + S_CT + i * 2) = (bf16)0;
        auto chunk_base = [&](int ci) -> int { if (ci < 2) { const int cx = dir ? (1 - ci) : ci; return T + b * CTXL + cx * 128; } const int cx = dir ? (63 - (ci - 2)) : (ci - 2); return b * SEQ + cx * 128; };
        if (w >= 4) {
            int ht = tid - 256; asm volatile("" : "+v"(ht));
            u32x4 pq[8], pk[8], pv[2]; float pga[2], pgk[8], pgt[8], pgl = 0.f, pgt8 = 0.f, pbt = 0.f, ppx = 0.f, mcar = 0.f;
            const float* GTL = (const float*)(a.ws + WS_GTILE);
            auto prefetchK = [&](int ci) {
                const int base = chunk_base(ci); const int gtb = (hd * 528 + (base >> 7)) * 8;
#pragma unroll
                for (int i = 0; i < 8; ++i) { const int p = ht + 256 * i, row = p >> 4, c16 = p & 15; const int tok = base + (dir ? 127 - row : row);
                    pk[i] = *(const u32x4*)(QKC + (size_t)tok * 1024 + 512 + h * 128 + c16 * 8);
                    pgk[i] = GS[(size_t)hd * TA + tok]; pgt[i] = GTL[gtb + i]; }
            };
            auto prefetch = [&](int ci) {
                const int base = chunk_base(ci); const int gtb = (hd * 528 + (base >> 7)) * 8;
#pragma unroll
                for (int i = 0; i < 8; ++i) { const int p = ht + 256 * i, row = p >> 4, c16 = p & 15; const int tok = base + (dir ? 127 - row : row);
                    pq[i] = *(const u32x4*)(QKC + (size_t)tok * 1024 + h * 128 + c16 * 8); }
#pragma unroll
                for (int i = 0; i < 2; ++i) { const int p = ht + 256 * i, row = p >> 2, cc = p & 3; const int tok = base + (dir ? 127 - row : row);
                    pv[i] = *(const u32x4*)(PV + (size_t)tok * 512 + h * 128 + vs * 32 + cc * 8); pga[i] = GTL[gtb + (row >> 4)]; }
                { const int row = ht & 127, arr = 1 + (ht >> 7); const int tok = base + (dir ? 127 - row : row); pgl = GS[(size_t)(arr * 8 + hd) * TA + tok]; }
                pgt8 = GTL[gtb + (ht & 7)];
                pbt = CH[(hd * 528 + (base >> 7)) * 2]; ppx = CH[(hd * 528 + (base >> 7)) * 2 + 1];
            };
            auto commitK = [&](int kbuf) {
#pragma unroll
                for (int i = 0; i < 8; ++i) { const int p = ht + 256 * i, row = p >> 4, c16 = p & 15; const float eg = __expf(pgk[i] - pgt[i]);
                    u32x4 o; o.x = pg8::cvt_pk_bf16(eg * bflo(pk[i].x), eg * bfhi(pk[i].x)); o.y = pg8::cvt_pk_bf16(eg * bflo(pk[i].y), eg * bfhi(pk[i].y));
                    o.z = pg8::cvt_pk_bf16(eg * bflo(pk[i].z), eg * bfhi(pk[i].z)); o.w = pg8::cvt_pk_bf16(eg * bflo(pk[i].w), eg * bfhi(pk[i].w));
                    *(LAS u32x4*)(L + kbuf + row * SP + c16 * 16) = o; } };
            auto commitQ = [&]() {
#pragma unroll
                for (int i = 0; i < 8; ++i) { const int p = ht + 256 * i, row = p >> 4, c16 = p & 15; *(LAS u32x4*)(L + S_QS + row * SP + c16 * 16) = pq[i]; } };
            auto commitV = [&](float mprev, int vabuf) {
#pragma unroll
                for (int i = 0; i < 2; ++i) { const int p = ht + 256 * i, row = p >> 2, cc = p & 3; const unsigned wv[4] = {pv[i].x, pv[i].y, pv[i].z, pv[i].w};
                    const float av = __expf(pga[i] - fmaxf(ppx, mprev));
#pragma unroll
                    for (int j = 0; j < 4; ++j) { const unsigned sc2 = pg8::cvt_pk_bf16(av * bflo(wv[j]), av * bfhi(wv[j]));
                        *(LAS bf16*)(L + S_VT + (cc * 8 + 2 * j) * SP + row * 2) = (bf16)(wv[j] & 0xffffu); *(LAS bf16*)(L + S_VT + (cc * 8 + 2 * j + 1) * SP + row * 2) = (bf16)(wv[j] >> 16);
                        *(LAS bf16*)(L + vabuf + (cc * 8 + 2 * j) * SP + row * 2) = (bf16)(sc2 & 0xffffu); *(LAS bf16*)(L + vabuf + (cc * 8 + 2 * j + 1) * SP + row * 2) = (bf16)(sc2 >> 16); }
                    if (cc == 0) *(LAS bf16*)(L + vabuf + 32 * SP + row * 2) = (bf16)f2bf(av); }
                *(LAS float*)(L + S_GL + (1 + (ht >> 7)) * 512 + (ht & 127) * 4) = pgl;
                if (ht < 8) *(LAS float*)(L + S_GL + ht * 4) = pgt8;
            };
            prefetchK(0); prefetch(0);
            LDS_BARRIER();
            commitK(S_K0); commitQ(); commitV(0.f, S_VA0);
            float btot = pbt, pmx = ppx;
            prefetchK(1);
            LDS_BARRIER();
            const int lw = blk * 4 + (w - 4);
            float cv[32]; bf16* cD = nullptr; int ck0 = 0, crow = 0;
            auto conv_load = [&](int it) {
                const float* cW; int cN, cn;
                if (it < 32768) { const int e = it >> 10, sb = it & 1023; ck0 = (sb >> 6) * 64; cn = (sb & 63) * 32 + (lane & 31); cN = 2048; cW = a.in[IN_W1] + (size_t)e * 1024 * 2048; cD = (bf16*)(a.ws + WS_W1T);
                    const int up = cn >= 1024, nn = cn & 1023; crow = e * 2048 + (nn >> 7) * 256 + up * 128 + (nn & 127); }
                else { const int it2 = it - 32768, e = it2 >> 9, sb = it2 & 511; ck0 = (sb >> 5) * 64; cn = (sb & 31) * 32 + (lane & 31); cN = 1024; cW = a.in[IN_W2] + (size_t)e * 1024 * 1024; cD = (bf16*)(a.ws + WS_W2T); crow = e * 1024 + cn; }
#pragma unroll
                for (int i = 0; i < 32; ++i) cv[i] = cW[(size_t)(ck0 + (lane >> 5) + 2 * i) * cN + cn];
            };
            auto conv_store = [&]() {
                const bool hi = lane >= 32;
                u32x4 o[4];
#pragma unroll
                for (int i = 0; i < 16; ++i) { const float snd = hi ? cv[i] : cv[16 + i]; const float rcv = __shfl_xor(snd, 32);
                    const unsigned pkd = pg8::cvt_pk_bf16(hi ? rcv : cv[i], hi ? cv[16 + i] : rcv);
                    if ((i & 3) == 0) o[i >> 2].x = pkd; else if ((i & 3) == 1) o[i >> 2].y = pkd; else if ((i & 3) == 2) o[i >> 2].z = pkd; else o[i >> 2].w = pkd; }
                u32x4* dst = (u32x4*)(cD + (size_t)crow * 1024 + ck0 + (hi ? 32 : 0));
#pragma unroll
                for (int j2 = 0; j2 < 4; ++j2) dst[j2] = o[j2];
            };
            conv_load(lw);
            for (int ci = 0; ci < 66; ++ci) {
                const float M127 = fmaxf(pmx, mcar), mnew = btot + M127;
                const int cnx = ci + 1 < 66 ? ci + 1 : 65, cn2 = ci + 2 < 66 ? ci + 2 : 65;
                commitK((ci & 1) ? S_K0 : S_K1);
                prefetch(cnx); prefetchK(cn2);
                if (ci < 48) conv_store();
                conv_load(lw + 1024 * ((ci + 1) % 48));
                LDS_BARRIER();
                mcar = mnew;
                commitQ(); commitV(mcar, (ci & 1) ? S_VA0 : S_VA1); btot = pbt; pmx = ppx;
                LDS_BARRIER();
            }
        } else {
            int c = lane & 15, q = lane >> 4; asm volatile("" : "+v"(c), "+v"(q));
            const int ta = w, tb = 7 - w, trA = 16 * ta + c, trB = 16 * tb + c;
            unsigned kadA[8];
#pragma unroll
            for (int ks = 0; ks < 4; ++ks)
#pragma unroll
                for (int t = 0; t < 2; ++t) kadA[ks * 2 + t] = (unsigned)((32 * ks + 8 * q + 4 * t + (c >> 2)) * SP + (4 * w + ((c & 3) >> 1)) * 16 + 8 * (c & 1));
            f32x4 accC[2][3];
#pragma unroll
            for (int d2 = 0; d2 < 2; ++d2)
#pragma unroll
                for (int i = 0; i < 3; ++i) accC[d2][i] = (f32x4){0.f, 0.f, 0.f, 0.f};
            float mcar = 0.f, pbt, ppx;
            { const int base0 = chunk_base(0); pbt = CH[(hd * 528 + (base0 >> 7)) * 2]; ppx = CH[(hd * 528 + (base0 >> 7)) * 2 + 1]; }
            LDS_BARRIER();
            float btot = pbt, pmx = ppx;
            LDS_BARRIER();
            const int npA = (ta + 2) >> 1, npB = (tb + 2) >> 1;
            for (int ci = 0; ci < 66; ++ci) {
                const int base = chunk_base(ci); const bool store = ci >= 2, more = ci + 1 < 66;
                const int kcur = (ci & 1) ? S_K1 : S_K0, vacur = (ci & 1) ? S_VA1 : S_VA0;
                const float M127 = fmaxf(pmx, mcar), cd = __expf(mcar - M127), mnew = btot + M127;
                if (more) { const int basen = chunk_base(ci + 1); pbt = CH[(hd * 528 + (basen >> 7)) * 2]; ppx = CH[(hd * 528 + (basen >> 7)) * 2 + 1]; }
                bf16x8 qfA[4], qfB[4];
                f32x4 acc3A[3], acc3B[3];
                {
                    bf16x8 cf[3][4];
#pragma unroll
                    for (int ks = 0; ks < 4; ++ks) { qfA[ks] = *(const LAS bf16x8*)(L + S_QS + trA * SP + (ks * 32 + q * 8) * 2); qfB[ks] = *(const LAS bf16x8*)(L + S_QS + trB * SP + (ks * 32 + q * 8) * 2); }
#pragma unroll
                    for (int mt = 0; mt < 3; ++mt)
#pragma unroll
                        for (int ks = 0; ks < 4; ++ks) cf[mt][ks] = *(const LAS bf16x8*)(L + S_CT + (16 * mt + c) * SP + (ks * 32 + q * 8) * 2);
                    LDS_WAIT(); __builtin_amdgcn_sched_barrier(0);
#pragma unroll
                    for (int mt = 0; mt < 3; ++mt) { acc3A[mt] = (f32x4){0.f, 0.f, 0.f, 0.f}; acc3B[mt] = (f32x4){0.f, 0.f, 0.f, 0.f};
#pragma unroll
                        for (int ks = 0; ks < 4; ++ks) { acc3A[mt] = __builtin_amdgcn_mfma_f32_16x16x32_bf16(cf[mt][ks], qfA[ks], acc3A[mt], 0, 0, 0); acc3B[mt] = __builtin_amdgcn_mfma_f32_16x16x32_bf16(cf[mt][ks], qfB[ks], acc3B[mt], 0, 0, 0); } }
                }
                const float MtA = fmaxf(PML[trA], mcar), MtB = fmaxf(PML[trB], mcar);
                const float decA = __expf(mcar - MtA), emtA = __expf(-(BL[trA] + MtA)), decB = __expf(mcar - MtB), emtB = __expf(-(BL[trB] + MtB));
                {
                    bf16x8 kf[2][4];
#pragma unroll
                    for (int u = 0; u < 2; ++u)
#pragma unroll
                        for (int ks = 0; ks < 4; ++ks) kf[u][ks] = *(const LAS bf16x8*)(L + kcur + (16 * u + c) * SP + (ks * 32 + q * 8) * 2);
                    for (int pr = 0; pr < npB; ++pr) {
                        LDS_WAIT(); __builtin_amdgcn_sched_barrier(0);
                        const bool doA = pr < npA;
                        f32x4 apA[2], apB[2];
                        const f32x2 gt2 = *(const LAS f32x2*)(GL + 2 * pr);
#pragma unroll
                        for (int u = 0; u < 2; ++u) { apA[u] = (f32x4){0.f, 0.f, 0.f, 0.f}; apB[u] = (f32x4){0.f, 0.f, 0.f, 0.f};
#pragma unroll
                            for (int ks = 0; ks < 4; ++ks) apB[u] = __builtin_amdgcn_mfma_f32_16x16x32_bf16(kf[u][ks], qfB[ks], apB[u], 0, 0, 0);
                            if (doA) {
#pragma unroll
                                for (int ks = 0; ks < 4; ++ks) apA[u] = __builtin_amdgcn_mfma_f32_16x16x32_bf16(kf[u][ks], qfA[ks], apA[u], 0, 0, 0); } }
                        __builtin_amdgcn_sched_barrier(0);
                        if (pr + 1 < npB) {
#pragma unroll
                            for (int u = 0; u < 2; ++u)
#pragma unroll
                                for (int ks = 0; ks < 4; ++ks) kf[u][ks] = *(const LAS bf16x8*)(L + kcur + (16 * (2 * pr + 2 + u) + c) * SP + (ks * 32 + q * 8) * 2);
                        }
#pragma unroll
                        for (int u = 0; u < 2; ++u) { const int s0 = 16 * (2 * pr + u) + 4 * q; const float gtv = u ? gt2.y : gt2.x;
                            const float emB = __expf(gtv - MtB);
                            float r[4];
#pragma unroll
                            for (int j = 0; j < 4; ++j) r[j] = (s0 + j <= trB) ? apB[u][j] * emB : 0.f;
                            u32x2 o; o.x = pg8::cvt_pk_bf16(r[0], r[1]); o.y = pg8::cvt_pk_bf16(r[2], r[3]);
                            *(LAS u32x2*)(L + S_QS + trB * SP + s0 * 2) = o;
                            if (doA) { const float emA = __expf(gtv - MtA);
#pragma unroll
                                for (int j = 0; j < 4; ++j) r[j] = (s0 + j <= trA) ? apA[u][j] * emA : 0.f;
                                o.x = pg8::cvt_pk_bf16(r[0], r[1]); o.y = pg8::cvt_pk_bf16(r[2], r[3]);
                                *(LAS u32x2*)(L + S_QS + trA * SP + s0 * 2) = o; } }
                    }
                }
                LDS_WAIT();
                f32x4 acc2A[3], acc2B[3];
#pragma unroll
                for (int mt = 0; mt < 3; ++mt) { acc2A[mt] = (f32x4){0.f, 0.f, 0.f, 0.f}; acc2B[mt] = (f32x4){0.f, 0.f, 0.f, 0.f}; }
                for (int ks = 0; ks < npB; ++ks) {
                    bf16x8 vf[3];
#pragma unroll
                    for (int mt = 0; mt < 3; ++mt) vf[mt] = *(const LAS bf16x8*)(L + S_VT + (16 * mt + c) * SP + (ks * 32 + q * 8) * 2);
                    const bf16x8 sB = *(const LAS bf16x8*)(L + S_QS + trB * SP + (ks * 32 + q * 8) * 2);
#pragma unroll
                    for (int mt = 0; mt < 3; ++mt) acc2B[mt] = __builtin_amdgcn_mfma_f32_16x16x32_bf16(vf[mt], sB, acc2B[mt], 0, 0, 0);
                    if (ks < npA) { const bf16x8 sA = *(const LAS bf16x8*)(L + S_QS + trA * SP + (ks * 32 + q * 8) * 2);
#pragma unroll
                        for (int mt = 0; mt < 3; ++mt) acc2A[mt] = __builtin_amdgcn_mfma_f32_16x16x32_bf16(vf[mt], sA, acc2A[mt], 0, 0, 0); }
                }
                {
                    const float denA = __shfl(acc2A[2][0] + decA * acc3A[2][0], c), denB = __shfl(acc2B[2][0] + decB * acc3B[2][0], c);
                    const float invA = frcp_(fmaxf(fabsf(denA), emtA)), invB = frcp_(fmaxf(fabsf(denB), emtB));
                    if (store) { const int tokA = base + (dir ? 127 - trA : trA), tokB = base + (dir ? 127 - trB : trB);
#pragma unroll
                        for (int mt = 0; mt < 2; ++mt) { const f32x4 vA = (acc2A[mt] + acc3A[mt] * decA) * invA, vB = (acc2B[mt] + acc3B[mt] * decB) * invB;
                            u32x2 o; o.x = pg8::cvt_pk_bf16(vA[0], vA[1]); o.y = pg8::cvt_pk_bf16(vA[2], vA[3]);
                            *(u32x2*)(HX + (size_t)tokA * 512 + h * 128 + vs * 32 + 16 * mt + 4 * q) = o;
                            o.x = pg8::cvt_pk_bf16(vB[0], vB[1]); o.y = pg8::cvt_pk_bf16(vB[2], vB[3]);
                            *(u32x2*)(HX + (size_t)tokB * 512 + h * 128 + vs * 32 + 16 * mt + 4 * q) = o; } }
                }
                LDS_BARRIER();
                {
                    bf16x8 vf[3][4];
#pragma unroll
                    for (int nt = 0; nt < 3; ++nt)
#pragma unroll
                        for (int ks = 0; ks < 4; ++ks) vf[nt][ks] = *(const LAS bf16x8*)(L + vacur + (16 * nt + c) * SP + (ks * 32 + q * 8) * 2);
#pragma unroll
                    for (int d2 = 0; d2 < 2; ++d2) {
                        unsigned ka[8];
#pragma unroll
                        for (int i = 0; i < 8; ++i) ka[i] = Lb + (unsigned)kcur + kadA[i] + (d2 ? 32u : 0u);
                        u32x2 kr[8]; tr_read_k8(kr, ka);
#pragma unroll
                        for (int nt = 0; nt < 3; ++nt) accC[d2][nt] = accC[d2][nt] * cd;
#pragma unroll
                        for (int ks = 0; ks < 4; ++ks) { const bf16x8 af = mk_frag(kr[ks * 2], kr[ks * 2 + 1]);
#pragma unroll
                            for (int nt = 0; nt < 3; ++nt) accC[d2][nt] = __builtin_amdgcn_mfma_f32_16x16x32_bf16(af, vf[nt][ks], accC[d2][nt], 0, 0, 0); }
#pragma unroll
                        for (int nt = 0; nt < 3; ++nt) { u32x2 o; o.x = pk2(accC[d2][nt][0], accC[d2][nt][1]); o.y = pk2(accC[d2][nt][2], accC[d2][nt][3]);
                            *(LAS u32x2*)(L + S_CT + (16 * nt + c) * SP + (16 * (2 * w + d2) + 4 * q) * 2) = o; }
                    }
                }
                mcar = mnew;
                if (more) { btot = pbt; pmx = ppx; }
                LDS_BARRIER();
            }
        }
    }
}

__device__ __forceinline__ void p5_pool_yb(const Args& a, const Frame& F) {
    const bf16* PP = (const bf16*)(a.ws + WS_PPOOL); bf16* PO_ = (bf16*)(a.ws + WS_POOLED);
    LAS unsigned char* L = F.lds;
    for (int item = F.bid; item < T / 64; item += F.G) {
        __syncthreads();
#pragma unroll
        for (int i = 0; i < 8; ++i) { const int p = F.tid + 512 * i, row = p >> 6, c16 = p & 63; *(LAS u32x4*)(L + row * 1024 + c16 * 16) = *(const u32x4*)(PP + (size_t)(item * 64 + row) * 512 + c16 * 8); }
        __syncthreads();
        const int cg = F.tid & 63, seg = F.tid >> 6, half = 1 << (cg >> 4), p0 = seg * 8;
        float sum[8];
#pragma unroll
        for (int j = 0; j < 8; ++j) sum[j] = 0.f;
        int lo = (p0 - half) > 0 ? (p0 - half) : 0, hi = (p0 + half) < 64 ? (p0 + half) : 64;
        for (int s2 = lo; s2 < hi; ++s2) { const u32x4 u = *(const LAS u32x4*)(L + s2 * 1024 + cg * 16);
            sum[0] += bflo(u.x); sum[1] += bfhi(u.x); sum[2] += bflo(u.y); sum[3] += bfhi(u.y); sum[4] += bflo(u.z); sum[5] += bfhi(u.z); sum[6] += bflo(u.w); sum[7] += bfhi(u.w); }
        for (int p = p0; p < p0 + 8; ++p) {
            const u32x4 u = *(const LAS u32x4*)(L + p * 1024 + cg * 16);
            const float ic = frcp_((float)(hi - lo));
            u32x4 o; o.x = pk2(sum[0] * ic - bflo(u.x), sum[1] * ic - bfhi(u.x)); o.y = pk2(sum[2] * ic - bflo(u.y), sum[3] * ic - bfhi(u.y));
            o.z = pk2(sum[4] * ic - bflo(u.z), sum[5] * ic - bfhi(u.z)); o.w = pk2(sum[6] * ic - bflo(u.w), sum[7] * ic - bfhi(u.w));
            *(u32x4*)(PO_ + (size_t)(item * 64 + p) * 512 + cg * 8) = o;
            const int nlo = (p + 1 - half) > 0 ? (p + 1 - half) : 0, nhi = (p + 1 + half) < 64 ? (p + 1 + half) : 64;
            if (nhi > hi) { const u32x4 v = *(const LAS u32x4*)(L + hi * 1024 + cg * 16);
                sum[0] += bflo(v.x); sum[1] += bfhi(v.x); sum[2] += bflo(v.y); sum[3] += bfhi(v.y); sum[4] += bflo(v.z); sum[5] += bfhi(v.z); sum[6] += bflo(v.w); sum[7] += bfhi(v.w); hi = nhi; }
            if (nlo > lo) { const u32x4 v = *(const LAS u32x4*)(L + lo * 1024 + cg * 16);
                sum[0] -= bflo(v.x); sum[1] -= bfhi(v.x); sum[2] -= bflo(v.y); sum[3] -= bfhi(v.y); sum[4] -= bflo(v.z); sum[5] -= bfhi(v.z); sum[6] -= bflo(v.w); sum[7] -= bfhi(v.w); lo = nlo; }
        }
    }
    const bf16* HF = (const bf16*)(a.ws + WS_HF); const bf16* HB = (const bf16*)(a.ws + WS_HB); const bf16* POg = (const bf16*)(a.ws + WS_PO); bf16* YB = (bf16*)(a.ws + WS_YB);
    const int gw = F.bid * 8 + F.wave, NGW = F.G * 8;
    const f32x4 hw0 = *(const f32x4*)(a.in[IN_HNW] + F.lane * 8), hw1 = *(const f32x4*)(a.in[IN_HNW] + F.lane * 8 + 4);
    const float hwv[8] = {hw0.x, hw0.y, hw0.z, hw0.w, hw1.x, hw1.y, hw1.z, hw1.w};
    for (int t0 = gw * 4; t0 < T; t0 += NGW * 4) {
        u32x4 f[4], bk[4], og[4];
#pragma unroll
        for (int u = 0; u < 4; ++u) { const size_t o = (size_t)(t0 + u) * 512 + F.lane * 8; f[u] = *(const u32x4*)(HF + o); bk[u] = *(const u32x4*)(HB + o); og[u] = *(const u32x4*)(POg + o); }
#pragma unroll
        for (int u = 0; u < 4; ++u) {
            float v[8];
            v[0] = bflo(f[u].x) + bflo(bk[u].x); v[1] = bfhi(f[u].x) + bfhi(bk[u].x); v[2] = bflo(f[u].y) + bflo(bk[u].y); v[3] = bfhi(f[u].y) + bfhi(bk[u].y);
            v[4] = bflo(f[u].z) + bflo(bk[u].z); v[5] = bfhi(f[u].z) + bfhi(bk[u].z); v[6] = bflo(f[u].w) + bflo(bk[u].w); v[7] = bfhi(f[u].w) + bfhi(bk[u].w);
            float s2 = 0.f;
#pragma unroll
            for (int jj = 0; jj < 8; ++jj) s2 += v[jj] * v[jj];
#pragma unroll
            for (int o = 1; o < 16; o <<= 1) s2 += __shfl_xor(s2, o);
            const float rstd = rsqrtf(s2 * (1.f / 128.f) + EPS);
            float gsig[8];
            gsig[0] = sigmoidf_(bflo(og[u].x)); gsig[1] = sigmoidf_(bfhi(og[u].x)); gsig[2] = sigmoidf_(bflo(og[u].y)); gsig[3] = sigmoidf_(bfhi(og[u].y));
            gsig[4] = sigmoidf_(bflo(og[u].z)); gsig[5] = sigmoidf_(bfhi(og[u].z)); gsig[6] = sigmoidf_(bflo(og[u].w)); gsig[7] = sigmoidf_(bfhi(og[u].w));
            float r[8];
#pragma unroll
            for (int jj = 0; jj < 8; ++jj) r[jj] = v[jj] * rstd * hwv[jj] * gsig[jj];
            u32x4 wv; wv.x = pg8::cvt_pk_bf16(r[0], r[1]); wv.y = pg8::cvt_pk_bf16(r[2], r[3]); wv.z = pg8::cvt_pk_bf16(r[4], r[5]); wv.w = pg8::cvt_pk_bf16(r[6], r[7]);
            *(u32x4*)(YB + (size_t)(t0 + u) * 512 + F.lane * 8) = wv;
        }
    }
}

__device__ __forceinline__ void moe_tables(const Args& a, const Frame& F) {
    LAS int* pst = (LAS int*)(F.misc + LM_PSTART); LAS unsigned char* tg = F.misc + LM_TILEG; LAS int* cxs = (LAS int*)(F.misc + LM_CX);
    LAS int* tmp = (LAS int*)F.lds; LAS int* Cpre = (LAS int*)(F.lds + 32768); LAS int* seg = (LAS int*)(F.lds + 65792);
    const int* cnt = (const int*)(a.ws + WS_CBASE);
    __syncthreads();
    for (int i = F.tid; i < 8192; i += 512) tmp[i] = cnt[i];
    if (F.tid == 0) cxs[0] = CX_MIN;
    __syncthreads();
    { const int e = F.tid & 31, sg = F.tid >> 5; int sacc = 0;
#pragma unroll
        for (int k = 0; k < 16; ++k) sacc += tmp[(sg * 16 + k) * 32 + e];
        seg[sg * 32 + e] = sacc; }
    __syncthreads();
    { const int e = F.tid & 31, sg = F.tid >> 5; int run = 0;
        for (int s2 = 0; s2 < sg; ++s2) run += seg[s2 * 32 + e];
#pragma unroll
        for (int k = 0; k < 16; ++k) { Cpre[(sg * 16 + k) * 32 + e] = run; run += tmp[(sg * 16 + k) * 32 + e]; }
        if (sg == 15) Cpre[256 * 32 + e] = run; }
    __syncthreads();
    if (F.tid >= CX_MIN && F.tid <= CX_MAX) { int tiles = 0;
        for (int e = 0; e < 32; ++e) tiles += (Cpre[F.tid * 32 + e] + 255) >> 8;
        if (tiles <= 512) atomicMax((int*)cxs, F.tid); }
    __syncthreads();
    if (F.tid == 0) { const int cx = cxs[0]; int acc = 0;
        for (int g = 0; g < NGRP; ++g) { pst[g] = acc; const int e = g & 31; const int c2 = g < 32 ? Cpre[cx * 32 + e] : Cpre[256 * 32 + e] - Cpre[cx * 32 + e]; acc += (c2 + 255) & ~255; }
        pst[NGRP] = acc; }
    __syncthreads();
    if (F.tid < NGRP) { const int t0 = pst[F.tid] >> 8, t1 = pst[F.tid + 1] >> 8; for (int t = t0; t < t1; ++t) tg[t] = (unsigned char)F.tid; }
    __syncthreads();
}

__device__ __forceinline__ void moe_tables_load(const Args& a, const Frame& F) {
    LAS int* pst = (LAS int*)(F.misc + LM_PSTART); LAS unsigned char* tg = F.misc + LM_TILEG; LAS int* cxs = (LAS int*)(F.misc + LM_CX);
    const int* tab = (const int*)(a.ws + WS_MOETAB);
    __syncthreads();
    if (F.tid < 65) pst[F.tid] = tab[F.tid];
    if (F.tid == 65) cxs[0] = tab[65];
    if (F.tid >= 128 && F.tid < 128 + 288) ((LAS int*)tg)[F.tid - 128] = tab[128 + F.tid - 128];
    __syncthreads();
}
__device__ __forceinline__ void p9_router(const Args& a, const Frame& F) {
    LAS unsigned char* Whi = F.lds; LAS unsigned char* Wlo = F.lds + 65536;
    LAS float* NWS = (LAS float*)(F.lds + 131072); LAS float* SHV = (LAS float*)(F.lds + 135168);
    LAS int* hist = (LAS int*)(F.lds + 139264);
    LAS float* red = (LAS float*)(F.lds + 139392);
    LAS f32x4* accb = (LAS f32x4*)(F.lds + 139904);
    const float* mod = (const float*)(a.ws + WS_MOD); bf16* H2 = (bf16*)(a.ws + WS_H2);
    int* cntg = (int*)(a.ws + WS_CBASE);
    int* ent_g = (int*)(a.ws + WS_ENT_G); int* ent_pos = (int*)(a.ws + WS_ENT_POS); float* ent_w = (float*)(a.ws + WS_ENT_W);
    const bf16* wr = (const bf16*)(a.ws + WS_WR_T);
    __syncthreads();
    for (int i = F.tid; i < 2 * 32 * 128; i += 512) { const int part = i >> 12, r = (i >> 7) & 31, c16 = i & 127;
        *(LAS u32x4*)((part ? Wlo : Whi) + r * 2048 + ((c16 ^ (r & 15)) << 4)) = *(const u32x4*)(wr + (size_t)part * 32768 + r * 1024 + c16 * 8); }
    const int c = F.lane & 15, q = F.lane >> 4, pair = F.wave >> 1;
    const float br0 = a.in[IN_BR][c], br1 = a.in[IN_BR][16 + c];
    for (int chunk = F.bid; chunk < T / 256; chunk += F.G) {
        const int bidx = (chunk * 256) >> 13;
        __syncthreads();
        if (F.tid < 32) hist[F.tid] = 0;
        for (int k = F.tid; k < 1024; k += 512) { NWS[k] = a.in[IN_N2W][k] * (1.0f + mod[bidx * 6144 + 4096 + k]); SHV[k] = mod[bidx * 6144 + 3072 + k]; }
        __syncthreads();
        for (int st = 0; st < 4; ++st) {
            const int tl0 = (st * 4 + pair) * 16, r = chunk * 256 + tl0 + c;
            f32x4 acc[2]; acc[0] = (f32x4){0.f, 0.f, 0.f, 0.f}; acc[1] = (f32x4){0.f, 0.f, 0.f, 0.f};
            norm_pair<2, true>(x1_row(a.out, a.ws, r), NWS, SHV, H2 + (size_t)r * D, Whi, Wlo, red, F.wave, c, q, acc);
            if (F.wave & 1) accb[pair * 64 + F.lane] = acc[0];
            LDS_BARRIER();
            if (!(F.wave & 1)) acc[0] += accb[pair * 64 + F.lane];
            LDS_BARRIER();
            if (F.wave & 1) accb[pair * 64 + F.lane] = acc[1];
            LDS_BARRIER();
            if (!(F.wave & 1)) {
                acc[1] += accb[pair * 64 + F.lane];
#pragma unroll
                for (int j = 0; j < 4; ++j) {
                    float v0 = acc[0][j] + br0, v1 = acc[1][j] + br1;
                    float tv[4]; int ti[4];
#pragma unroll
                    for (int k = 0; k < 4; ++k) {
                        float bv; int bi; if (v1 > v0) { bv = v1; bi = 16 + c; } else { bv = v0; bi = c; }
#pragma unroll
                        for (int o = 1; o < 16; o <<= 1) { const float ov = __shfl_xor(bv, o); const int oi = __shfl_xor(bi, o); if (ov > bv || (ov == bv && oi < bi)) { bv = ov; bi = oi; } }
                        tv[k] = bv; ti[k] = bi; if (bi == c) v0 = -INFINITY; if (bi == 16 + c) v1 = -INFINITY;
                    }
                    const float e1 = __expf(tv[1] - tv[0]), e2 = __expf(tv[2] - tv[0]), e3 = __expf(tv[3] - tv[0]); const float inv = 1.0f / (1.0f + e1 + e2 + e3);
                    if (c < 4) { const int e = c == 0 ? ti[0] : c == 1 ? ti[1] : c == 2 ? ti[2] : ti[3]; const float wgt = (c == 0 ? 1.0f : c == 1 ? e1 : c == 2 ? e2 : e3) * inv;
                        const int lp = atomicAdd((int*)(hist + e), 1);
                        const size_t gi = (size_t)(chunk * 256 + tl0 + 4 * q + j) * 4 + c; ent_g[gi] = e; ent_pos[gi] = lp; ent_w[gi] = wgt; }
                }
            }
        }
        __syncthreads();
        if (F.tid < 32) cntg[chunk * 32 + F.tid] = hist[F.tid];
    }
}

__device__ __forceinline__ void p10_scatter(const Args& a, const Frame& F) {
    moe_tables(a, F);
    LAS int* pst = (LAS int*)(F.misc + LM_PSTART); const LAS int* Cpre = (const LAS int*)(F.lds + 32768);
    const int cx = ((const LAS int*)(F.misc + LM_CX))[0];
    if (F.bid == 0) { int* tab = (int*)(a.ws + WS_MOETAB);
        if (F.tid < 65) tab[F.tid] = pst[F.tid];
        if (F.tid == 65) tab[65] = cx;
        if (F.tid >= 128 && F.tid < 128 + 288) tab[128 + F.tid - 128] = ((const LAS int*)(F.misc + LM_TILEG))[F.tid - 128]; }
    const int* ent_g = (const int*)(a.ws + WS_ENT_G); const int* ent_pos = (const int*)(a.ws + WS_ENT_POS);
    int* row_tok = (int*)(a.ws + WS_ROW_TOK); int* tok_row = (int*)(a.ws + WS_TOK_ROW);
    for (int idx = F.bid * 512 + F.tid; idx < T * 4; idx += F.G * 512) {
        const int e = ent_g[idx], chunk = idx >> 10, part = chunk >= cx ? 1 : 0, t = idx >> 2;
        const int r = pst[part * 32 + e] + Cpre[chunk * 32 + e] - (part ? Cpre[cx * 32 + e] : 0) + ent_pos[idx];
        row_tok[r] = t; tok_row[idx] = r;
    }
    for (int g = F.bid; g < NGRP; g += F.G) { const int e = g & 31; const int c2 = g < 32 ? Cpre[cx * 32 + e] : Cpre[256 * 32 + e] - Cpre[cx * 32 + e]; const int r0 = pst[g] + c2, r1 = pst[g + 1];
        for (int r = r0 + F.tid; r < r1; r += 512) row_tok[r] = 0; }
}

__device__ __forceinline__ void p_final(const Args& a, const Frame& F, int half) {
    moe_tables_load(a, F);
    const int rowbase = half ? ((const LAS int*)(F.misc + LM_PSTART))[32] : 0;
    const int X = 256 * ((const LAS int*)(F.misc + LM_CX))[0], tbeg = half ? X : 0, tend = half ? T : X;
    const float* mod = (const float*)(a.ws + WS_MOD); const bf16* OUTK = (const bf16*)(a.ws + WS_OUTK);
    const int* tok_row = (const int*)(a.ws + WS_TOK_ROW); const float* ent_w = (const float*)(a.ws + WS_ENT_W);
    const int gw = F.bid * 8 + F.wave, NGW = F.G * 8;
    const f32x4* fw = (const f32x4*)a.in[IN_FNW] + F.lane;
    int rkn[4]; float wkn[4];
    { const int t0 = tbeg + gw; if (t0 < tend) {
#pragma unroll
        for (int k = 0; k < 4; ++k) { rkn[k] = tok_row[t0 * 4 + k] - rowbase; wkn[k] = ent_w[t0 * 4 + k]; } } }
    for (int t = tbeg + gw; t < tend; t += NGW) {
        f32x4* xr = (f32x4*)(a.out + (size_t)t * D) + F.lane;
        const u32x2* x1p = (const u32x2*)x1_row(a.out, a.ws, t) + F.lane;
        const f32x4* g2 = (const f32x4*)(mod + (t >> 13) * 6144 + 5120) + F.lane;
        int rk[4]; float wk[4];
#pragma unroll
        for (int k = 0; k < 4; ++k) { rk[k] = rkn[k]; wk[k] = wkn[k]; }
        u32x2 ok[4][4], xw[4];
#pragma unroll
        for (int j = 0; j < 4; ++j) { xw[j] = x1p[64 * j];
#pragma unroll
            for (int k = 0; k < 4; ++k) ok[j][k] = *((const u32x2*)(OUTK + (size_t)rk[k] * D) + F.lane + 64 * j); }
        { const int tn = t + NGW; if (tn < tend) {
#pragma unroll
            for (int k = 0; k < 4; ++k) { rkn[k] = tok_row[tn * 4 + k] - rowbase; wkn[k] = ent_w[tn * 4 + k]; } } }
        f32x4 v[4]; float s = 0.f;
#pragma unroll
        for (int j = 0; j < 4; ++j) {
            f32x4 m = (f32x4){0.f, 0.f, 0.f, 0.f};
#pragma unroll
            for (int k = 0; k < 4; ++k) { const u32x2 o = ok[j][k]; m.x += wk[k] * bflo(o.x); m.y += wk[k] * bfhi(o.x); m.z += wk[k] * bflo(o.y); m.w += wk[k] * bfhi(o.y); }
            v[j] = (f32x4){bflo(xw[j].x), bfhi(xw[j].x), bflo(xw[j].y), bfhi(xw[j].y)} + g2[64 * j] * m;
            s += (v[j].x * v[j].x + v[j].y * v[j].y) + (v[j].z * v[j].z + v[j].w * v[j].w);
        }
        const float rstd = rsqrtf(wave_sum(s) * (1.f / D) + EPS);
#pragma unroll
        for (int j = 0; j < 4; ++j) xr[64 * j] = v[j] * rstd * fw[64 * j];
    }
}

__global__ void __launch_bounds__(512, 2) mk_fwd(Args args) {
    extern __shared__ __attribute__((aligned(16))) unsigned char lds_raw[];
    Frame F;
    F.lds = (LAS unsigned char*)lds_raw; F.misc = F.lds + LDS_MAIN;
    F.tid = threadIdx.x; F.lane = F.tid & 63; F.wave = __builtin_amdgcn_readfirstlane(F.tid >> 6); F.G = gridDim.x; F.bid = blockIdx.x;
    unsigned char* ws = args.ws;
    const int lo = args.ph_lo, hi = args.ph_hi;
    if (F.tid < 4) ((LAS unsigned*)(F.misc + LM_BAR))[F.tid] = 0u;
    __syncthreads();
    XcdBarrier bar; bar.bar = (unsigned*)(ws + WS_CTL) + CW_BAR; bar.x = 0; bar.st = nullptr;
    if (hi - lo > 1) bar = xcd_barrier_post((unsigned*)(ws + WS_CTL) + CW_BAR, (volatile LAS unsigned*)(F.misc + LM_BAR));
#define IN(k) (lo <= (k) && (k) < hi)
#define SEAM(k) do { if (IN(k) && IN((k) + 1)) xcd_barrier(bar); } while (0)

    if (IN(0)) { p0_prologue(args, F); } SEAM(0);
    if (IN(1)) { p1_xn(args, F); } SEAM(1);
    if (IN(2)) {
        pg8::Gemm g{(const bf16*)(ws + WS_XN), (const bf16*)(ws + WS_WIN_T), 1024, nullptr, nullptr, nullptr};
        SchedIn S{F.G, F.bid};
        EpiIn E{(bf16*)(ws + WS_PPOOL), (bf16*)(ws + WS_PQK), (bf16*)(ws + WS_PV), (bf16*)(ws + WS_PO), (bf16*)(ws + WS_PMERGE)};
        pg8::gemm_phase<EpiIn, SchedIn, false>(F.lds, g, S, E);
    } SEAM(2);
    if (IN(3)) { p3_conv(args, F); } SEAM(3);
    if (IN(4)) { p4_scan(args, F); } SEAM(4);
    if (IN(5)) { p5_pool_yb(args, F); } SEAM(5);
    if (IN(6)) {
        pg8::Gemm g{(const bf16*)(ws + WS_POOLED), (const bf16*)(ws + WS_WPA_T), 512, nullptr, (const bf16*)(ws + WS_YB), (const bf16*)(ws + WS_WBM_T)};
        SchedMerge S{F.G, F.bid};
        EpiMerge E{(const bf16*)(ws + WS_PMERGE), (bf16*)(ws + WS_Y)};
        pg8::gemm_phase<EpiMerge, SchedMerge, false, true>(F.lds, g, S, E);
    } SEAM(6);
    if (IN(8)) {
        pg8::Gemm g{(const bf16*)(ws + WS_Y), (const bf16*)(ws + WS_WOUT_T), 1024, nullptr, nullptr, nullptr};
        pg8::StaticOrder S{256, 4, F.G, F.bid};
        EpiOut E{args.in[IN_X], (const float*)(ws + WS_MOD), args.out, ws};
        pg8::gemm_phase<EpiOut, pg8::StaticOrder, false>(F.lds, g, S, E);
    } SEAM(8);
    if (IN(9)) { p9_router(args, F); } SEAM(9);
    if (IN(10)) { p10_scatter(args, F); } SEAM(10);
    if (IN(11)) {
        moe_tables_load(args, F);
        const LAS int* pst = (const LAS int*)(F.misc + LM_PSTART);
        pg8::Gemm g{(const bf16*)(ws + WS_H2), (const bf16*)(ws + WS_W1T), 1024, (const int*)(ws + WS_ROW_TOK), nullptr, nullptr};
        SchedMoe S{F.G, F.bid, 8, 0, pst[NGRP] >> 8, (const LAS unsigned char*)(F.misc + LM_TILEG)};
        EpiMoe1 E{args.in[IN_B1], (bf16*)(ws + WS_ACT)};
        pg8::gemm_phase<EpiMoe1, SchedMoe, true>(F.lds, g, S, E);
    } SEAM(11);
    if (IN(12)) {
        moe_tables_load(args, F);
        const LAS int* pst = (const LAS int*)(F.misc + LM_PSTART);
        pg8::Gemm g{(const bf16*)(ws + WS_ACT), (const bf16*)(ws + WS_W2T), 1024, nullptr, nullptr, nullptr};
        SchedMoe S{F.G, F.bid, 4, 0, pst[32] >> 8, (const LAS unsigned char*)(F.misc + LM_TILEG)};
        EpiMoe2 E{args.in[IN_B2], (bf16*)(ws + WS_OUTK), 0};
        pg8::gemm_phase<EpiMoe2, SchedMoe, false>(F.lds, g, S, E);
    } SEAM(12);
    if (IN(13)) { p_final(args, F, 0); } SEAM(13);
    if (IN(14)) {
        moe_tables_load(args, F);
        const LAS int* pst = (const LAS int*)(F.misc + LM_PSTART);
        pg8::Gemm g{(const bf16*)(ws + WS_ACT), (const bf16*)(ws + WS_W2T), 1024, nullptr, nullptr, nullptr};
        SchedMoe S{F.G, F.bid, 4, pst[32] >> 8, pst[NGRP] >> 8, (const LAS unsigned char*)(F.misc + LM_TILEG)};
        EpiMoe2 E{args.in[IN_B2], (bf16*)(ws + WS_OUTK), pst[32]};
        pg8::gemm_phase<EpiMoe2, SchedMoe, false>(F.lds, g, S, E);
    } SEAM(14);
    if (IN(15)) { p_final(args, F, 1); }
#undef IN
#undef SEAM
}

extern "C" void kernel_launch(void* const* d_in, const int* in_sizes, int n_in, void* d_out, int out_size, void* d_ws, size_t ws_size, hipStream_t stream) {
    static int grid = 0;
    if (grid == 0) {
        if (n_in != 25 || out_size != T * D || ws_size < WS_END) { fprintf(stderr, "kernel_launch: unexpected shapes (n_in %d out %d ws %zu)\n", n_in, out_size, ws_size); grid = -1; return; }
        int dev = 0, cus = 0, per_cu = 0;
        if (hipGetDevice(&dev) != hipSuccess || hipDeviceGetAttribute(&cus, hipDeviceAttributeMultiprocessorCount, dev) != hipSuccess) { grid = -1; return; }
        if (hipFuncSetAttribute((const void*)mk_fwd, hipFuncAttributeMaxDynamicSharedMemorySize, LDS_BYTES) != hipSuccess) { fprintf(stderr, "kernel_launch: hipFuncSetAttribute failed\n"); grid = -1; return; }
        if (hipOccupancyMaxActiveBlocksPerMultiprocessor(&per_cu, (const void*)mk_fwd, 512, LDS_BYTES) != hipSuccess || per_cu < 1) fprintf(stderr, "kernel_launch: occupancy query says %d\n", per_cu);
        (void)hipGetLastError();
        grid = cus;
    }
    if (grid < 0) return;
    (void)hipMemsetAsync((char*)d_ws + WS_CTL, 0, CTL_BYTES, stream);
    Args a{};
    for (int i = 0; i < 25; ++i) a.in[i] = (const float*)d_in[i];
    a.out = (float*)d_out; a.ws = (unsigned char*)d_ws;
#if MK_MULTI
    for (int p = 0; p < NPHASE; ++p) { a.ph_lo = p; a.ph_hi = p + 1; hipLaunchKernelGGL(mk_fwd, dim3(grid), dim3(512), LDS_BYTES, stream, a); }
#else
    a.ph_lo = 0; a.ph_hi = NPHASE;
    hipLaunchKernelGGL(mk_fwd, dim3(grid), dim3(512), LDS_BYTES, stream, a);
#endif
}
```

```cpp
#include <hip/hip_runtime.h>
#include <cstdio>
#include <cstdint>

#ifndef MK_MULTI
#define MK_MULTI 0
#endif

#define LAS __attribute__((address_space(3)))
#define GAS __attribute__((address_space(1)))
typedef unsigned short bf16;
typedef short bf16x8 __attribute__((ext_vector_type(8)));
typedef float f32x4 __attribute__((ext_vector_type(4)));
typedef float f32x2 __attribute__((ext_vector_type(2)));
typedef unsigned u32x4 __attribute__((ext_vector_type(4)));
typedef unsigned u32x2 __attribute__((ext_vector_type(2)));

constexpr int D = 1024, NBATCH = 8, SEQ = 8192, T = NBATCH * SEQ, CTXL = 256, TCX = NBATCH * CTXL, TA = T + TCX;
constexpr int INW = 4624;
constexpr int NEXP = 32, NGRP = 64;
constexpr int XSPLIT = 30720;
constexpr int CX_MIN = 121, CX_MAX = 128;
constexpr int MAXROWS = T * 4 + NGRP * 256;
constexpr int NPHASE = 16;
constexpr float EPS = 1e-6f;

constexpr size_t MiB = 1u << 20;
constexpr size_t WS_CTL = 0, CTL_BYTES = 1 * MiB;
constexpr size_t WS_MOD = 1 * MiB;
constexpr size_t WS_ENT_G = 2 * MiB, WS_ENT_POS = 3 * MiB, WS_ENT_W = 4 * MiB;
constexpr size_t WS_ROW_TOK = 5 * MiB;
constexpr size_t WS_TOK_ROW = 9 * MiB;
constexpr size_t WS_CBASE = 6 * MiB + 512 * 1024;
constexpr size_t WS_MOETAB = 10 * MiB + 512 * 1024;
constexpr size_t WS_GATES = 11 * MiB;
constexpr size_t WS_WIN_T = 16 * MiB;
constexpr size_t WS_WPA_T = 26 * MiB, WS_WBM_T = 27 * MiB, WS_WOUT_T = 28 * MiB;
constexpr size_t WS_WG_T = 30 * MiB;
constexpr size_t WS_WR_T = 31 * MiB;
constexpr size_t WS_GS = 32 * MiB;
constexpr size_t WS_CHK = 39 * MiB;
constexpr size_t WS_XN = 40 * MiB;
constexpr size_t WS_QKC = 40 * MiB, WS_POOLED = 40 * MiB, WS_YB = 104 * MiB;
constexpr size_t WS_PQK = 172 * MiB;
constexpr size_t WS_HF = 172 * MiB, WS_HB = 236 * MiB, WS_Y = 172 * MiB;
constexpr size_t WS_PPOOL = 304 * MiB, WS_PV = 368 * MiB, WS_PO = 434 * MiB, WS_PMERGE = 498 * MiB;
constexpr size_t WS_W1T = 754 * MiB, WS_W2T = 882 * MiB;
constexpr size_t WS_ACT = 40 * MiB, WS_H2 = 626 * MiB, WS_OUTK = 585 * MiB;
constexpr size_t WS_X1B = 946 * MiB;
constexpr size_t WS_END = 1014 * MiB;
static_assert((size_t)MAXROWS * 2048 <= (626 - 40) * MiB, "ACT fits");
constexpr int CW_BAR = 4096;
constexpr int CW_GCNT = 16384;

constexpr int LDS_MAIN = 131072, LDS_BYTES = 147456;
constexpr int LM_BAR = 16368, LM_PSTART = 8704, LM_CX = 8704 + 272, LM_TILEG = 9216;

__device__ __forceinline__ unsigned f2bf(float f) { unsigned u = __builtin_bit_cast(unsigned, f); return (u + 0x7fffu + ((u >> 16) & 1u)) >> 16; }
__device__ __forceinline__ unsigned pk2(float lo, float hi) { return f2bf(lo) | (f2bf(hi) << 16); }
__device__ __forceinline__ float bflo(unsigned w) { return __uint_as_float(w << 16); }
__device__ __forceinline__ float bfhi(unsigned w) { return __uint_as_float(w & 0xffff0000u); }
__device__ __forceinline__ float bf2f(bf16 h) { return __uint_as_float(((unsigned)h) << 16); }
__device__ __forceinline__ float fexp_(float x) { return __builtin_amdgcn_exp2f(x * 1.4426950408889634f); }
__device__ __forceinline__ float frcp_(float x) { return __builtin_amdgcn_rcpf(x); }
__device__ __forceinline__ float sigmoidf_(float x) { return frcp_(1.0f + fexp_(-x)); }
__device__ __forceinline__ float wave_sum(float v) {
#pragma unroll
    for (int o = 1; o < 64; o <<= 1) v += __shfl_xor(v, o);
    return v;
}
#define LDS_WAIT() asm volatile("s_waitcnt lgkmcnt(0)" ::: "memory")
#define VM_WAIT() asm volatile("s_waitcnt vmcnt(0)" ::: "memory")
#define LDS_BARRIER() do { asm volatile("s_waitcnt lgkmcnt(0)" ::: "memory"); __builtin_amdgcn_s_barrier(); asm volatile("" ::: "memory"); } while (0)

#define XB_TMO      128
#define XB_XCNT(j)  (256  + 64 * (j))
#define XB_XSUB(j)  (1280 + 64 * (j))
#define XB_XGEN(j)  (2304 + 64 * (j))
#define XB_TOP      3328
#define XB_TOPGEN   3392
#define XCD_BAR_WORDS 3456
#define XB_SPIN_CAP (1u << 18)
__device__ __forceinline__ unsigned xb_ld(unsigned* p)              { return __hip_atomic_load(p, __ATOMIC_RELAXED, __HIP_MEMORY_SCOPE_AGENT); }
__device__ __forceinline__ unsigned xb_add(unsigned* p, unsigned v) { return __hip_atomic_fetch_add(p, v, __ATOMIC_RELAXED, __HIP_MEMORY_SCOPE_AGENT); }
__device__ __forceinline__ unsigned xb_xcc_id() { return (unsigned)__builtin_amdgcn_s_getreg((3 << 11) | 20) & 0xFu; }
#define XB_SPIN(cond, bar) do { unsigned _sp = 0; while (cond) { __builtin_amdgcn_s_sleep(1); \
    if ((++_sp & 255u) == 0u) { if (xb_ld(&(bar)[XB_TMO])) break; if (_sp > XB_SPIN_CAP) { atomicAdd(&(bar)[XB_TMO], 1u); break; } } } } while (0)
struct XcdBarrier { unsigned* bar; unsigned x; volatile LAS unsigned* st; };
__device__ __forceinline__ XcdBarrier xcd_barrier_post(unsigned* bar, volatile LAS unsigned* st) {
    XcdBarrier b; b.bar = bar; b.x = xb_xcc_id(); b.st = st;
    if (threadIdx.x == 0) (void)xb_add(&bar[XB_XCNT(b.x)], 1u);
    return b;
}
__device__ __forceinline__ void xcd_barrier_complete(unsigned* bar, unsigned x, unsigned& nloc, unsigned& nx) {
    const unsigned G = gridDim.x * gridDim.y * gridDim.z;
    unsigned sum, cnt, mine, sp = 0u;
    for (;;) {
        sum = 0u; cnt = 0u; mine = 0u;
#pragma unroll
        for (unsigned j = 0; j < 16; ++j) { const unsigned c = xb_ld(&bar[XB_XCNT(j)]); sum += c; cnt += (c > 0u) ? 1u : 0u; mine = (j == x) ? c : mine; }
        if (sum == G) break;
        __builtin_amdgcn_s_sleep(1);
        if ((++sp & 255u) == 0u) { if (xb_ld(&bar[XB_TMO])) break; if (sp > XB_SPIN_CAP) { atomicAdd(&bar[XB_TMO], 1u); break; } }
    }
    nloc = mine > 0u ? mine : 1u; nx = cnt > 0u ? cnt : 1u;
}
__device__ __forceinline__ void xcd_barrier(const XcdBarrier& b) {
    asm volatile("s_waitcnt vmcnt(0)" ::: "memory");
    __syncthreads();
    if (threadIdx.x == 0) {
        unsigned* bar = b.bar;
        __builtin_amdgcn_s_waitcnt(0);
        unsigned nloc = b.st[0], nx = b.st[1];
        if (nloc == 0u) { xcd_barrier_complete(bar, b.x, nloc, nx); b.st[0] = nloc; b.st[1] = nx; }
        const unsigned old = xb_add(&bar[XB_XSUB(b.x)], 1u);
        const unsigned gen = old / nloc;
        if (old + 1u == (gen + 1u) * nloc) {
            __builtin_amdgcn_fence(__ATOMIC_RELEASE, "agent");
            asm volatile("s_waitcnt vmcnt(0)" ::: "memory");
            const unsigned og = xb_add(&bar[XB_TOP], 1u);
            const unsigned tg = og / nx;
            if (og + 1u == (tg + 1u) * nx) xb_add(&bar[XB_TOPGEN], 1u);
            else XB_SPIN(xb_ld(&bar[XB_TOPGEN]) == tg, bar);
            __builtin_amdgcn_fence(__ATOMIC_ACQUIRE, "agent");
            xb_add(&bar[XB_XGEN(b.x)], 1u);
            asm volatile("s_waitcnt vmcnt(0)" ::: "memory");
        } else {
            XB_SPIN(xb_ld(&bar[XB_XGEN(b.x)]) == gen, bar);
            __builtin_amdgcn_fence(__ATOMIC_ACQUIRE, "agent");
            asm volatile("s_waitcnt vmcnt(0)" ::: "memory");
        }
    }
    __syncthreads();
}

namespace pg8 {
constexpr int BM = 256, BK = 64, HALF = 128, HTB = HALF * BK * 2, STAGE_BYTES = 8 * HTB;
__device__ __forceinline__ int lds_byte(int r, int c) { const int st = (r >> 4) * 2 + (c >> 5), rr = r & 15, cc = c & 31, ob = rr * 64 + cc * 2; return st * 1024 + (ob ^ (((ob >> 9) & 1) << 5)); }
__device__ __forceinline__ void stage_rc(int b, int& R, int& C) { const int st = b / 1024, sb = b % 1024, swz = sb ^ (((sb >> 9) & 1) << 5); R = (st >> 1) * 16 + swz / 64; C = (st & 1) * 32 + (swz % 64) / 2; }
__device__ __forceinline__ int perm32(int rho) { const int n = rho >> 4, i = rho & 15; return 8 * (i >> 2) + 4 * n + (i & 3); }
struct Unit { int pm, pn; };
struct Gemm { const bf16* A; const bf16* Bt; int K; const int* rowidx; const bf16* A2; const bf16* Bt2; };

__device__ __forceinline__ void static_unit(int wgid, int nM, int nN, Unit& u) {
    const int nwg = nM * nN;
    { const int q = nwg / 8, r = nwg % 8, xcd = wgid % 8, off = wgid / 8; wgid = (xcd < r ? xcd * (q + 1) : r * (q + 1) + (xcd - r) * q) + off; }
    const int nig = 8 * nN, gid = wgid / nig, fm = gid * 8, gsz = (nM - fm) < 8 ? (nM - fm) : 8;
    u.pm = fm + ((wgid % nig) % gsz); u.pn = (wgid % nig) / gsz;
}
struct StaticOrder { int nM, nN, G, c;
    __device__ __forceinline__ bool next(int i, Unit& u) const { const long L = (long)i * G + c; if (L >= (long)nM * nN) return false; static_unit((int)L, nM, nN, u); return true; } };

__device__ __forceinline__ unsigned cvt_pk_bf16(float lo, float hi) { unsigned r; asm volatile("v_cvt_pk_bf16_f32 %0, %1, %2" : "=v"(r) : "v"(lo), "v"(hi)); return r; }

template <class Epi, class Sched, bool GATHER, bool DUAL = false>
__device__ __forceinline__ void gemm_phase(LAS unsigned char* lds, const Gemm g, const Sched& S, const Epi& E) {
    const int tid = threadIdx.x, wid = __builtin_amdgcn_readfirstlane(tid >> 6), lane = tid & 63, wr = wid >> 2, wc = wid & 3, fr = lane & 15, fq = lane >> 4;
    const int K = g.K, nt = K / BK;
    int sR[2], sC[2]; unsigned voffB[2];
#pragma unroll
    for (int i = 0; i < 2; ++i) { int R, C; stage_rc(tid * 16 + i * 8192, R, C); sR[i] = R; sC[i] = C; const int Rb = Epi::PERM ? ((R & ~31) + perm32(R & 31)) : R; voffB[i] = (unsigned)(Rb * K + C) * 2u; }
    const size_t kstep = (size_t)(BK * 2);
    const size_t hstep = (size_t)HALF * K * 2;
    const size_t tstep = 2 * hstep;
    const unsigned ldsw = (unsigned)wid * 1024u;
    const int aoff = lds_byte(wr * 64 + fr, fq * 8), boff = lds_byte(wc * 32 + fr, fq * 8);
#define PG8_SA(b, h) (((b) * 2 + (h)) * HTB)
#define PG8_SB(b, h) ((4 + (b) * 2 + (h)) * HTB)
#define PG8_STAGE(bufoff, gbase, voff) do { _Pragma("unroll") for (int _i = 0; _i < 2; ++_i) \
        __builtin_amdgcn_global_load_lds((const unsigned*)((const char*)(gbase) + (voff)[_i]), (LAS unsigned*)(lds + (bufoff) + ldsw + _i * 8192), 16, 0, 0); } while (0)
#define PG8_STAGEA(bufoff, ab, kb, ofs) do { _Pragma("unroll") for (int _i = 0; _i < 2; ++_i) \
        __builtin_amdgcn_global_load_lds((const unsigned*)((ab) + (kb) + (ofs)[_i]), (LAS unsigned*)(lds + (bufoff) + ldsw + _i * 8192), 16, 0, 0); } while (0)
#define PG8_LDA(dst, b, h) do { _Pragma("unroll") for (int m = 0; m < 4; ++m) _Pragma("unroll") for (int k = 0; k < 2; ++k) dst[m][k] = *(const LAS bf16x8*)(lds + PG8_SA(b, h) + aoff + m * 2048 + k * 1024); } while (0)
#define PG8_LDB(dst, b, h) do { _Pragma("unroll") for (int n = 0; n < 2; ++n) _Pragma("unroll") for (int k = 0; k < 2; ++k) dst[n][k] = *(const LAS bf16x8*)(lds + PG8_SB(b, h) + boff + n * 2048 + k * 1024); } while (0)
#define PG8_MMA(ai, bj, At, Bt) do { __builtin_amdgcn_s_setprio(1); _Pragma("unroll") for (int m = 0; m < 4; ++m) _Pragma("unroll") for (int n = 0; n < 2; ++n) _Pragma("unroll") for (int k = 0; k < 2; ++k) \
        acc[ai][bj][m][n] = __builtin_amdgcn_mfma_f32_16x16x32_bf16(Bt[n][k], At[m][k], acc[ai][bj][m][n], 0, 0, 0); __builtin_amdgcn_s_setprio(0); } while (0)
#define PG8_WAIT_V(n) asm volatile("s_waitcnt vmcnt(" #n ")" ::: "memory")
#define PG8_WAIT_L(n) asm volatile("s_waitcnt lgkmcnt(" #n ")" ::: "memory")
#define PG8_BAR __builtin_amdgcn_s_barrier()
#define PG8_SCHED __builtin_amdgcn_sched_barrier(0)
#define PG8_ROWOFS(dst, u) do { _Pragma("unroll") for (int _h = 0; _h < 2; ++_h) _Pragma("unroll") for (int _i = 0; _i < 2; ++_i) { \
        const int _r = (u).pm * BM + _h * HALF + sR[_i]; const unsigned _row = GATHER ? (unsigned)g.rowidx[_r] : (unsigned)_r; \
        dst[_h][_i] = (_row * (unsigned)K + (unsigned)sC[_i]) * 2u; } } while (0)
#define PG8_ROWRAW(dst, u) do { _Pragma("unroll") for (int _h = 0; _h < 2; ++_h) _Pragma("unroll") for (int _i = 0; _i < 2; ++_i) \
        dst[_h][_i] = (unsigned)g.rowidx[(u).pm * BM + _h * HALF + sR[_i]]; } while (0)
#define PG8_RAW2OFS(dst, raw) do { _Pragma("unroll") for (int _h = 0; _h < 2; ++_h) _Pragma("unroll") for (int _i = 0; _i < 2; ++_i) \
        dst[_h][_i] = (raw[_h][_i] * (unsigned)K + (unsigned)sC[_i]) * 2u; } while (0)
    Unit cur, nxt; int ui = 0;
    if (!S.next(0, cur)) return;
    f32x4 acc[2][2][4][2];
    f32x4 nb[2][2];
#pragma unroll
    for (int b = 0; b < 2; ++b)
#pragma unroll
        for (int n = 0; n < 2; ++n) nb[b][n] = (f32x4){0.f, 0.f, 0.f, 0.f};
    if constexpr (Epi::HAS_BIAS) E.load_bias(nb, cur, wc, fq);
#pragma unroll
    for (int a = 0; a < 2; ++a)
#pragma unroll
        for (int b = 0; b < 2; ++b)
#pragma unroll
            for (int m = 0; m < 4; ++m)
#pragma unroll
                for (int n = 0; n < 2; ++n) acc[a][b][m][n] = nb[b][n];
    bf16x8 At[4][2], B0[2][2], B1[2][2];
    unsigned cofs[2][2], nofs[2][2];
    PG8_ROWOFS(cofs, cur);
    bool has_next = S.next(1, nxt);
    unsigned nraw[2][2];
    if (GATHER && has_next) PG8_ROWRAW(nraw, nxt);
    const char* cAb = (const char*)((DUAL && (cur.pn >> 16)) ? g.A2 : g.A);
    const char* cB = (const char*)((DUAL && (cur.pn >> 16)) ? g.Bt2 : g.Bt) + (size_t)(cur.pn & 0xffff) * tstep;
    PG8_STAGE(PG8_SB(0, 0), cB, voffB); PG8_STAGE(PG8_SB(0, 1), cB + hstep, voffB); PG8_STAGEA(PG8_SA(0, 0), cAb, 0, cofs[0]); PG8_STAGEA(PG8_SA(0, 1), cAb, 0, cofs[1]);
    if (wr == 1) PG8_BAR;
    PG8_WAIT_V(2); PG8_BAR;
    PG8_STAGE(PG8_SB(1, 0), cB + kstep, voffB); PG8_STAGEA(PG8_SA(1, 0), cAb, kstep, cofs[0]); PG8_STAGE(PG8_SB(1, 1), cB + hstep + kstep, voffB);
    PG8_WAIT_V(6); PG8_BAR;
    for (;;) {
        if (has_next) { if (GATHER) { PG8_RAW2OFS(nofs, nraw); } else { PG8_ROWOFS(nofs, nxt); } }
        else {
#pragma unroll
            for (int h = 0; h < 2; ++h)
#pragma unroll
                for (int i = 0; i < 2; ++i) nofs[h][i] = cofs[h][i];
        }
        Unit n2; const bool has_n2 = has_next && S.next(ui + 2, n2);
        if (GATHER && has_n2) PG8_ROWRAW(nraw, n2);
        const char* nB = has_next ? (const char*)((DUAL && (nxt.pn >> 16)) ? g.Bt2 : g.Bt) + (size_t)(nxt.pn & 0xffff) * tstep : cB;
        const char* nAb = has_next ? (const char*)((DUAL && (nxt.pn >> 16)) ? g.A2 : g.A) : cAb;
        for (int t = 0; t < nt; t += 2) {
            const bool last = (t == nt - 2);
            const size_t k1 = (size_t)(t + 1) * kstep;
            const size_t k2 = last ? 0 : (size_t)(t + 2) * kstep; const size_t k3 = k2 + kstep;
            const char* b2 = last ? nB : cB + (size_t)(t + 2) * kstep; const char* b3 = b2 + kstep;
            const char* ab2 = last ? nAb : cAb;
            unsigned o2[2][2];
#pragma unroll
            for (int h = 0; h < 2; ++h)
#pragma unroll
                for (int i = 0; i < 2; ++i) o2[h][i] = last ? nofs[h][i] : cofs[h][i];
            PG8_LDB(B0, 0, 0); PG8_LDB(B1, 0, 1); PG8_SCHED; PG8_LDA(At, 0, 0); PG8_STAGEA(PG8_SA(1, 1), cAb, k1, cofs[1]);
            PG8_WAIT_V(8); PG8_WAIT_L(0); PG8_BAR; PG8_MMA(0, 0, At, B0); PG8_MMA(0, 1, At, B1); PG8_BAR; PG8_SCHED;
            PG8_LDA(At, 0, 1); PG8_STAGE(PG8_SB(0, 0), b2, voffB); PG8_STAGE(PG8_SB(0, 1), b2 + hstep, voffB); PG8_STAGEA(PG8_SA(0, 0), ab2, k2, o2[0]);
            PG8_WAIT_V(8); PG8_WAIT_L(0); PG8_BAR; PG8_MMA(1, 0, At, B0); PG8_MMA(1, 1, At, B1); PG8_BAR; PG8_SCHED;
            PG8_LDB(B0, 1, 0); PG8_LDB(B1, 1, 1); PG8_SCHED; PG8_LDA(At, 1, 0); PG8_STAGEA(PG8_SA(0, 1), ab2, k2, o2[1]);
            PG8_WAIT_V(8); PG8_WAIT_L(0); PG8_BAR; PG8_MMA(0, 0, At, B0); PG8_MMA(0, 1, At, B1); PG8_BAR; PG8_SCHED;
            PG8_LDA(At, 1, 1); PG8_STAGE(PG8_SB(1, 0), b3, voffB); PG8_STAGE(PG8_SB(1, 1), b3 + hstep, voffB); PG8_STAGEA(PG8_SA(1, 0), ab2, k3, o2[0]);
            PG8_WAIT_V(8); PG8_WAIT_L(0); PG8_BAR; PG8_MMA(1, 0, At, B0); PG8_MMA(1, 1, At, B1); PG8_BAR; PG8_SCHED;
        }
        if (wr == 0) PG8_BAR;
        if constexpr (Epi::HAS_BIAS) { if (has_next) E.load_bias(nb, nxt, wc, fq); }
        E(acc, cur, wr, wc, fr, fq);
        if (!has_next) break;
        if (!DUAL || (cur.pn >> 16)) {
#pragma unroll
        for (int a = 0; a < 2; ++a)
#pragma unroll
            for (int b = 0; b < 2; ++b)
#pragma unroll
                for (int m = 0; m < 4; ++m)
#pragma unroll
                    for (int n = 0; n < 2; ++n) acc[a][b][m][n] = nb[b][n];
        }
        cur = nxt; cB = nB; cAb = nAb; ++ui; nxt = n2; has_next = has_n2;
#pragma unroll
        for (int h = 0; h < 2; ++h)
#pragma unroll
            for (int i = 0; i < 2; ++i) cofs[h][i] = nofs[h][i];
        if (wr == 1) PG8_BAR;
    }
    PG8_WAIT_V(0);
    PG8_BAR;
#undef PG8_SA
#undef PG8_SB
#undef PG8_STAGE
#undef PG8_STAGEA
#undef PG8_LDA
#undef PG8_LDB
#undef PG8_MMA
#undef PG8_WAIT_V
#undef PG8_WAIT_L
#undef PG8_BAR
#undef PG8_SCHED
#undef PG8_ROWOFS
#undef PG8_ROWRAW
#undef PG8_RAW2OFS
}
}
using pg8::Unit;
typedef f32x4 AccT[2][2][4][2];

struct Args { const float* in[25]; float* out; unsigned char* ws; int ph_lo, ph_hi; };
struct Frame { LAS unsigned char* lds; LAS unsigned char* misc; int tid, lane, wave, G, bid; };

#define IN_X 0
#define IN_C 1
#define IN_CTX 2
#define IN_CCTX 3
#define IN_WADA 4
#define IN_BADA 5
#define IN_N1W 6
#define IN_WIN 7
#define IN_GATEB 8
#define IN_CONVW 9
#define IN_CONVB 10
#define IN_WPOOL 11
#define IN_PSCALE 12
#define IN_HNW 13
#define IN_WBP 14
#define IN_WBM 15
#define IN_WOUT 16
#define IN_N2W 17
#define IN_WR 18
#define IN_BR 19
#define IN_W1 20
#define IN_B1 21
#define IN_W2 22
#define IN_B2 23
#define IN_FNW 24

__device__ __forceinline__ bf16* x1_row(float* out, unsigned char* ws, int t) { return t < XSPLIT ? (bf16*)out + (size_t)T * D + (size_t)t * D : (bf16*)(ws + WS_X1B) + (size_t)(t - XSPLIT) * D; }
template <class RowMap>
__device__ __forceinline__ void tr_item(const float* W, int K, int N, bf16* WT, LAS float* scr, int item, int lane, const RowMap& rowmap) {
    const int nblk = (N + 31) / 32, kb = item / nblk, nb = item % nblk, k0 = 64 * kb, n0 = 32 * nb;
    const int nn = n0 + (lane & 31);
#pragma unroll
    for (int i = 0; i < 32; ++i) { const int kk = 2 * i + (lane >> 5); scr[kk * 33 + (lane & 31)] = (nn < N) ? W[(size_t)(k0 + kk) * N + nn] : 0.f; }
    LDS_WAIT(); asm volatile("" ::: "memory");
    const int c = lane & 7;
#pragma unroll
    for (int j = 0; j < 4; ++j) { const int n = (lane >> 3) + 8 * j; const LAS float* s = scr + (8 * c) * 33 + n;
        u32x4 o; o.x = pk2(s[0 * 33], s[1 * 33]); o.y = pk2(s[2 * 33], s[3 * 33]); o.z = pk2(s[4 * 33], s[5 * 33]); o.w = pk2(s[6 * 33], s[7 * 33]);
        if (n0 + n < N) *(u32x4*)(WT + (size_t)rowmap(n0 + n) * K + k0 + 8 * c) = o; }
    LDS_WAIT(); asm volatile("" ::: "memory");
}
struct MapId { int off; __device__ __forceinline__ int operator()(int n) const { return off + n; } };
struct MapWin { __device__ __forceinline__ int operator()(int c) const { return c < 2560 ? c : (c < 2576 ? 4608 + (c - 2560) : c - 16); } };
struct MapW1 { int off; __device__ __forceinline__ int operator()(int n) const { const int up = n >= 1024, nn = n & 1023; return off + (nn >> 7) * 256 + up * 128 + (nn & 127); } };

__device__ __forceinline__ void p0_prologue(const Args& a, const Frame& F) {
    LAS float* scr = (LAS float*)(F.lds + F.wave * 8448);
    LAS float* sc = (LAS float*)(F.lds + 69632);
    LAS float* red = (LAS float*)(F.lds + 106496);
    unsigned char* ws = a.ws;
    for (int item = F.bid; item < 96; item += F.G) {
        __syncthreads();
        for (int i = F.tid; i < 9 * 1024; i += 512) { const int r = i >> 10, k = i & 1023; const float v = (r < 8) ? a.in[IN_C][r * 1024 + k] : a.in[IN_CCTX][k]; sc[i] = v * sigmoidf_(v); }
        __syncthreads();
        const int col = 64 * item + F.lane, k0 = F.wave * 128; const float* W = a.in[IN_WADA] + col;
        float acc[9];
#pragma unroll
        for (int q = 0; q < 9; ++q) acc[q] = 0.f;
        for (int kk = 0; kk < 128; kk += 8) {
            float wv[8];
#pragma unroll
            for (int u = 0; u < 8; ++u) wv[u] = W[(size_t)(k0 + kk + u) * 6144];
#pragma unroll
            for (int q = 0; q < 9; ++q) { const f32x4 s0 = *(const LAS f32x4*)(sc + q * 1024 + k0 + kk), s1 = *(const LAS f32x4*)(sc + q * 1024 + k0 + kk + 4);
                acc[q] += (s0.x * wv[0] + s0.y * wv[1]) + (s0.z * wv[2] + s0.w * wv[3]) + (s1.x * wv[4] + s1.y * wv[5]) + (s1.z * wv[6] + s1.w * wv[7]); }
        }
#pragma unroll
        for (int q = 0; q < 9; ++q) red[(F.wave * 9 + q) * 64 + F.lane] = acc[q];
        __syncthreads();
        for (int i = F.tid; i < 9 * 64; i += 512) { const int q = i >> 6, l = i & 63; float s = 0.f;
#pragma unroll
            for (int w8 = 0; w8 < 8; ++w8) s += red[(w8 * 9 + q) * 64 + l];
            ((float*)(ws + WS_MOD))[q * 6144 + 64 * item + l] = s + a.in[IN_BADA][64 * item + l]; }
    }
    __syncthreads();
    const int gw = F.bid * 8 + F.wave, NGW = F.G * 8;
    constexpr int I_WPA = 1024, I_WRT = 32, I_WGT = 16, I_WIN = 16 * 145, I_WBM = 8 * 32, I_WOUT = 16 * 32;
    constexpr int NITEMS = I_WPA + I_WRT + I_WGT + I_WIN + I_WBM + I_WOUT;
    for (int it = gw; it < NITEMS; it += NGW) {
        int r = it;
        if (r < I_WPA) {
            const int g = r >> 8, cb = (r >> 4) & 15, n = (r & 15) * 64 + F.lane, k0 = g * 128 + cb * 8;
            const float* wp = a.in[IN_WPOOL] + (size_t)k0 * 128; const float* ps = a.in[IN_PSCALE] + g * 128; const float* wb = a.in[IN_WBP] + (size_t)(g * 128) * 1024 + n;
            float acc[8];
#pragma unroll
            for (int cc = 0; cc < 8; ++cc) acc[cc] = 0.f;
#pragma unroll 4
            for (int d = 0; d < 128; ++d) { const float wbv = wb[(size_t)d * 1024] * ps[d];
#pragma unroll
                for (int cc = 0; cc < 8; ++cc) acc[cc] += wp[cc * 128 + d] * wbv; }
            u32x4 o; o.x = pk2(acc[0], acc[1]); o.y = pk2(acc[2], acc[3]); o.z = pk2(acc[4], acc[5]); o.w = pk2(acc[6], acc[7]);
            *(u32x4*)((bf16*)(ws + WS_WPA_T) + (size_t)n * 512 + k0) = o;
            continue;
        }
        r -= I_WPA;
        if (r < I_WRT + I_WGT) {
            const bool isr = r < I_WRT; const int e = isr ? r : r - I_WRT; bf16* dst = (bf16*)(ws + (isr ? WS_WR_T : WS_WG_T)); const int nrow = isr ? 32 : 16;
#pragma unroll 4
            for (int i = 0; i < 16; ++i) { const int k = F.lane + 64 * i; const float v = isr ? a.in[IN_WR][k * 32 + e] : a.in[IN_WIN][(size_t)k * INW + 2560 + e];
                const unsigned hi = f2bf(v); const float rem = v - __uint_as_float(hi << 16);
                dst[e * 1024 + k] = (bf16)hi; dst[(nrow + e) * 1024 + k] = (bf16)f2bf(rem); }
            continue;
        }
        r -= I_WRT + I_WGT;
        if (r < I_WIN) { tr_item(a.in[IN_WIN], 1024, INW, (bf16*)(ws + WS_WIN_T), scr, r, F.lane, MapWin{}); continue; } r -= I_WIN;
        if (r < I_WBM) { tr_item(a.in[IN_WBM], 512, 1024, (bf16*)(ws + WS_WBM_T), scr, r, F.lane, MapId{0}); continue; } r -= I_WBM;
        tr_item(a.in[IN_WOUT], 1024, 1024, (bf16*)(ws + WS_WOUT_T), scr, r, F.lane, MapId{0});
    }
}

template <int NT, bool XBF16>
__device__ __forceinline__ void norm_pair(const void* xrow, const LAS float* nwsL, const LAS float* shL, bf16* orow, const LAS unsigned char* Whi, const LAS unsigned char* Wlo,
                                          LAS float* red, int wave, int c, int q, f32x4 (&acc)[NT]) {
    const int hf = wave & 1;
    f32x4 xa[16], xb[16];
    if (XBF16) {
        const u32x4* xp = (const u32x4*)xrow + 64 * hf + q;
        u32x4 xr[16];
#pragma unroll
        for (int j = 0; j < 16; ++j) xr[j] = xp[j * 4];
#pragma unroll
        for (int j = 0; j < 16; ++j) { xa[j] = (f32x4){bflo(xr[j].x), bfhi(xr[j].x), bflo(xr[j].y), bfhi(xr[j].y)}; xb[j] = (f32x4){bflo(xr[j].z), bfhi(xr[j].z), bflo(xr[j].w), bfhi(xr[j].w)}; }
    } else {
        const f32x4* xp = (const f32x4*)xrow + 128 * hf + 2 * q;
#pragma unroll
        for (int j = 0; j < 16; ++j) { xa[j] = xp[j * 8]; xb[j] = xp[j * 8 + 1]; }
    }
    float ss = 0.f;
#pragma unroll
    for (int j = 0; j < 16; ++j) ss += ((xa[j].x * xa[j].x + xa[j].y * xa[j].y) + (xa[j].z * xa[j].z + xa[j].w * xa[j].w)) + ((xb[j].x * xb[j].x + xb[j].y * xb[j].y) + (xb[j].z * xb[j].z + xb[j].w * xb[j].w));
    ss += __shfl_xor(ss, 16); ss += __shfl_xor(ss, 32);
    if (q == 0) red[wave * 16 + c] = ss;
    LDS_BARRIER();
    const float rstd = rsqrtf((red[wave * 16 + c] + red[(wave ^ 1) * 16 + c]) * (1.f / 1024.f) + EPS);
    const LAS f32x4* np = (const LAS f32x4*)nwsL + 128 * hf + 2 * q; const LAS f32x4* hp = (const LAS f32x4*)shL + 128 * hf + 2 * q;
    u32x4* op = (u32x4*)orow + 64 * hf + q;
#pragma unroll
    for (int j = 0; j < 16; ++j) {
        const f32x4 y0 = (xa[j] * rstd) * np[j * 8] + hp[j * 8], y1 = (xb[j] * rstd) * np[j * 8 + 1] + hp[j * 8 + 1];
        u32x4 hi; hi.x = pg8::cvt_pk_bf16(y0.x, y0.y); hi.y = pg8::cvt_pk_bf16(y0.z, y0.w); hi.z = pg8::cvt_pk_bf16(y1.x, y1.y); hi.w = pg8::cvt_pk_bf16(y1.z, y1.w);
        op[j * 4] = hi;
        u32x4 lo; lo.x = pg8::cvt_pk_bf16(y0.x - bflo(hi.x), y0.y - bfhi(hi.x)); lo.y = pg8::cvt_pk_bf16(y0.z - bflo(hi.y), y0.w - bfhi(hi.y));
        lo.z = pg8::cvt_pk_bf16(y1.x - bflo(hi.z), y1.y - bfhi(hi.z)); lo.w = pg8::cvt_pk_bf16(y1.z - bflo(hi.w), y1.w - bfhi(hi.w));
        const bf16x8 ah = __builtin_bit_cast(bf16x8, hi), al = __builtin_bit_cast(bf16x8, lo);
        const int wo = (((4 * (16 * hf + j) + q) ^ c) << 4);
#pragma unroll
        for (int nt = 0; nt < NT; ++nt) { const bf16x8 bh = *(const LAS bf16x8*)(Whi + (16 * nt + c) * 2048 + wo), bl = *(const LAS bf16x8*)(Wlo + (16 * nt + c) * 2048 + wo);
            acc[nt] = __builtin_amdgcn_mfma_f32_16x16x32_bf16(ah, bh, acc[nt], 0, 0, 0); acc[nt] = __builtin_amdgcn_mfma_f32_16x16x32_bf16(al, bh, acc[nt], 0, 0, 0); acc[nt] = __builtin_amdgcn_mfma_f32_16x16x32_bf16(ah, bl, acc[nt], 0, 0, 0); }
    }
}
__device__ __forceinline__ void p1_xn(const Args& a, const Frame& F) {
    LAS unsigned char* Whi = F.lds; LAS unsigned char* Wlo = F.lds + 32768;
    LAS float* NWS = (LAS float*)(F.lds + 65536); LAS float* SHV = (LAS float*)(F.lds + 65536 + 8192);
    LAS float* red = (LAS float*)(F.lds + 81920);
    LAS f32x4* accb = (LAS f32x4*)(F.lds + 82432);
    const bf16* wg = (const bf16*)(a.ws + WS_WG_T);
    const float* mod = (const float*)(a.ws + WS_MOD);
    const int c = F.lane & 15, q = F.lane >> 4, pair = F.wave >> 1;
    bf16* XN = (bf16*)(a.ws + WS_XN); float* GT = (float*)(a.ws + WS_GATES);
    for (int blk = F.bid; blk < 256; blk += F.G) {
        const int mrb = blk >> 5;
        __syncthreads();
        for (int i = F.tid; i < 2 * 16 * 128; i += 512) { const int part = i >> 11, r = (i >> 7) & 15, c16 = i & 127;
            *(LAS u32x4*)((part ? Wlo : Whi) + r * 2048 + ((c16 ^ r) << 4)) = *(const u32x4*)(wg + (size_t)part * 16384 + r * 1024 + c16 * 8); }
        for (int i = F.tid; i < 2 * 1024; i += 512) { const int mr = (i >> 10) ? 8 : mrb, k = i & 1023; NWS[i] = a.in[IN_N1W][k] * (1.0f + mod[mr * 6144 + 1024 + k]); SHV[i] = mod[mr * 6144 + k]; }
        __syncthreads();
        const int nstep = (blk < 32) ? 5 : 4;
        for (int st = 0; st < nstep; ++st) {
            const bool isctx = st == 4;
            const int tile = isctx ? (T / 16 + blk * 4 + pair) : (blk * 16 + st * 4 + pair);
            const int r = tile * 16 + c;
            const float* src = isctx ? a.in[IN_CTX] + (size_t)(r - T) * D : a.in[IN_X] + (size_t)r * D;
            f32x4 acc[1]; acc[0] = (f32x4){0.f, 0.f, 0.f, 0.f};
            norm_pair<1, false>(src, NWS + (isctx ? 1024 : 0), SHV + (isctx ? 1024 : 0), XN + (size_t)r * D, Whi, Wlo, red, F.wave, c, q, acc);
            if (F.wave & 1) accb[pair * 64 + F.lane] = acc[0];
            LDS_BARRIER();
            if (!(F.wave & 1)) { const f32x4 o = acc[0] + accb[pair * 64 + F.lane];
#pragma unroll
                for (int j = 0; j < 4; ++j) GT[(size_t)(tile * 16 + 4 * q + j) * 16 + c] = o[j]; }
        }
    }
}

struct SchedIn { int G, c;
    __device__ __forceinline__ bool next(int i, Unit& u) const {
        long L = (long)i * G + c;
        if (L < 256 * 18) { pg8::static_unit((int)L, 256, 18, u); return true; }
        L -= 256 * 18; if (L >= 48) return false;
        u.pm = 256 + (int)(L / 6); u.pn = 2 + (int)(L % 6); return true; } };
__device__ __forceinline__ unsigned pk4_fp8(float a, float b, float c, float d) { int p = __builtin_amdgcn_cvt_pk_fp8_f32(a, b, 0, false); p = __builtin_amdgcn_cvt_pk_fp8_f32(c, d, p, true); return (unsigned)p; }
__device__ __forceinline__ void un4_fp8(unsigned w, float (&o)[4]) { const auto lo = __builtin_amdgcn_cvt_pk_f32_fp8((int)w, false), hi = __builtin_amdgcn_cvt_pk_f32_fp8((int)w, true); o[0] = lo[0]; o[1] = lo[1]; o[2] = hi[0]; o[3] = hi[1]; }
struct EpiIn { static constexpr bool PERM = true, HAS_BIAS = false;
    bf16 *ppool, *pqk, *pv, *po; unsigned char* pmerge;
    __device__ __forceinline__ void operator()(AccT& acc, const Unit& u, int wr, int wc, int fr, int fq) const {
        const int row0 = u.pm * 256 + wr * 64 + fr, pn = u.pn;
        if (pn >= 10) {
            const int col0 = 256 * (pn - 10) + wc * 32 + 8 * fq;
#pragma unroll
            for (int ai = 0; ai < 2; ++ai)
#pragma unroll
                for (int m = 0; m < 4; ++m) { unsigned char* rowp = pmerge + (size_t)(row0 + ai * 128 + m * 16) * 2048 + col0;
#pragma unroll
                    for (int bj = 0; bj < 2; ++bj) { f32x4 v0 = acc[ai][bj][m][0], v1 = acc[ai][bj][m][1];
                        asm volatile("" : "+v"(v0), "+v"(v1));
                        u32x2 w; w.x = pk4_fp8(v0[0], v0[1], v0[2], v0[3]); w.y = pk4_fp8(v1[0], v1[1], v1[2], v1[3]);
                        *(u32x2*)(rowp + bj * 128) = w; } }
            return;
        }
        bf16* base; int ld, colt;
        if (pn < 2) { base = ppool; ld = 512; colt = 256 * pn; } else if (pn < 6) { base = pqk; ld = 1024; colt = 256 * (pn - 2); }
        else if (pn < 8) { base = pv; ld = 512; colt = 256 * (pn - 6); } else { base = po; ld = 512; colt = 256 * (pn - 8); }
        const int col0 = colt + wc * 32 + 8 * fq;
#pragma unroll
        for (int ai = 0; ai < 2; ++ai)
#pragma unroll
            for (int m = 0; m < 4; ++m) { bf16* rowp = base + (size_t)(row0 + ai * 128 + m * 16) * ld + col0;
#pragma unroll
                for (int bj = 0; bj < 2; ++bj) { const f32x4 v0 = acc[ai][bj][m][0], v1 = acc[ai][bj][m][1];
                    u32x4 w; w.x = pg8::cvt_pk_bf16(v0[0], v0[1]); w.y = pg8::cvt_pk_bf16(v0[2], v0[3]); w.z = pg8::cvt_pk_bf16(v1[0], v1[1]); w.w = pg8::cvt_pk_bf16(v1[2], v1[3]);
                    *(u32x4*)(rowp + bj * 128) = w; } }
    } };
struct SchedMerge { int G, c;
    __device__ __forceinline__ bool next(int i, Unit& u) const { const long L = (long)(i >> 1) * G + c; if (L >= 1024) return false; pg8::static_unit((int)L, 256, 4, u); u.pn |= (i & 1) << 16; return true; } };
struct EpiMerge { static constexpr bool PERM = true, HAS_BIAS = false;
    const unsigned char* pmerge; bf16* Y;
    __device__ __forceinline__ void operator()(AccT& acc, const Unit& u, int wr, int wc, int fr, int fq) const {
        const int sel = u.pn >> 16, pn = u.pn & 0xffff;
        const int row0 = u.pm * 256 + wr * 64 + fr, col0 = pn * 256 + wc * 32 + 8 * fq;
#define RAT(aw, bw) ((1.0f + fexp_(-(bw))) * frcp_(1.0f + fexp_(-(aw))))
        if (sel == 0) {
            u32x2 ga[2][4][2], gb[2][4][2];
#pragma unroll
            for (int ai = 0; ai < 2; ++ai)
#pragma unroll
                for (int m = 0; m < 4; ++m)
#pragma unroll
                    for (int bj = 0; bj < 2; ++bj) { const unsigned char* p = pmerge + (size_t)(row0 + ai * 128 + m * 16) * 2048 + col0 + bj * 128; ga[ai][m][bj] = *(const u32x2*)p; gb[ai][m][bj] = *(const u32x2*)(p + 1024); }
#pragma unroll
            for (int ai = 0; ai < 2; ++ai)
#pragma unroll
                for (int m = 0; m < 4; ++m)
#pragma unroll
                    for (int bj = 0; bj < 2; ++bj) { f32x4& v0 = acc[ai][bj][m][0]; f32x4& v1 = acc[ai][bj][m][1];
                        float a0[4], a1[4], b0[4], b1[4]; un4_fp8(ga[ai][m][bj].x, a0); un4_fp8(ga[ai][m][bj].y, a1); un4_fp8(gb[ai][m][bj].x, b0); un4_fp8(gb[ai][m][bj].y, b1);
#pragma unroll
                        for (int j = 0; j < 4; ++j) { v0[j] *= RAT(a0[j], b0[j]); v1[j] *= RAT(a1[j], b1[j]); } }
        } else {
            u32x2 gb[2][4][2];
#pragma unroll
            for (int ai = 0; ai < 2; ++ai)
#pragma unroll
                for (int m = 0; m < 4; ++m)
#pragma unroll
                    for (int bj = 0; bj < 2; ++bj) gb[ai][m][bj] = *(const u32x2*)(pmerge + (size_t)(row0 + ai * 128 + m * 16) * 2048 + 1024 + col0 + bj * 128);
#pragma unroll
            for (int ai = 0; ai < 2; ++ai)
#pragma unroll
                for (int m = 0; m < 4; ++m)
#pragma unroll
                    for (int bj = 0; bj < 2; ++bj) { const f32x4 v0 = acc[ai][bj][m][0], v1 = acc[ai][bj][m][1];
                        float b0[4], b1[4]; un4_fp8(gb[ai][m][bj].x, b0); un4_fp8(gb[ai][m][bj].y, b1);
                        u32x4 w; w.x = pg8::cvt_pk_bf16(sigmoidf_(b0[0]) * v0[0], sigmoidf_(b0[1]) * v0[1]); w.y = pg8::cvt_pk_bf16(sigmoidf_(b0[2]) * v0[2], sigmoidf_(b0[3]) * v0[3]);
                        w.z = pg8::cvt_pk_bf16(sigmoidf_(b1[0]) * v1[0], sigmoidf_(b1[1]) * v1[1]); w.w = pg8::cvt_pk_bf16(sigmoidf_(b1[2]) * v1[2], sigmoidf_(b1[3]) * v1[3]);
                        *(u32x4*)(Y + (size_t)(row0 + ai * 128 + m * 16) * 1024 + col0 + bj * 128) = w; }
        }
#undef RAT
    } };
struct EpiOut { static constexpr bool PERM = true, HAS_BIAS = false;
    const float* x; const float* mod; float* out; unsigned char* ws;
    __device__ __forceinline__ void operator()(AccT& acc, const Unit& u, int wr, int wc, int fr, int fq) const {
        const int row0 = u.pm * 256 + wr * 64 + fr, col0 = u.pn * 256 + wc * 32 + 8 * fq;
        const float* g1 = mod + (u.pm >> 5) * 6144 + 2048 + col0;
        f32x4 gv[2][2];
#pragma unroll
        for (int bj = 0; bj < 2; ++bj)
#pragma unroll
            for (int n = 0; n < 2; ++n) gv[bj][n] = *(const f32x4*)(g1 + bj * 128 + n * 4);
        bf16* x1b = x1_row(out, ws, u.pm * 256);
#pragma unroll
        for (int ai = 0; ai < 2; ++ai) {
            f32x4 xv[4][2][2];
#pragma unroll
            for (int m = 0; m < 4; ++m)
#pragma unroll
                for (int bj = 0; bj < 2; ++bj)
#pragma unroll
                    for (int n = 0; n < 2; ++n) xv[m][bj][n] = *(const f32x4*)(x + (size_t)(row0 + ai * 128 + m * 16) * 1024 + col0 + bj * 128 + n * 4);
#pragma unroll
            for (int m = 0; m < 4; ++m)
#pragma unroll
                for (int bj = 0; bj < 2; ++bj) { const f32x4 v0 = xv[m][bj][0] + gv[bj][0] * acc[ai][bj][m][0], v1 = xv[m][bj][1] + gv[bj][1] * acc[ai][bj][m][1];
                    u32x4 w; w.x = pg8::cvt_pk_bf16(v0[0], v0[1]); w.y = pg8::cvt_pk_bf16(v0[2], v0[3]); w.z = pg8::cvt_pk_bf16(v1[0], v1[1]); w.w = pg8::cvt_pk_bf16(v1[2], v1[3]);
                    *(u32x4*)(x1b + (size_t)(wr * 64 + fr + ai * 128 + m * 16) * 1024 + col0 + bj * 128) = w; }
            asm volatile("" ::: "memory");
        }
    } };
struct SchedMoe { int G, c, NT, tlo, thi; const LAS unsigned char* tile_g;
    __device__ __forceinline__ bool next(int i, Unit& u) const {
        int tile, pnl;
        if (G == 256) { const int x = c & 7, j = c >> 3, tpx = 32 / NT; tile = tlo + i * (8 * tpx) + x * tpx + j / NT; pnl = j % NT; }
        else { const long L = (long)i * G + c; tile = tlo + (int)(L / NT); pnl = (int)(L % NT); }
        if (tile >= thi) return false;
        const int e = tile_g[tile] & 31; u.pm = tile; u.pn = e * NT + pnl; return true; } };
struct EpiMoe1 { static constexpr bool PERM = true, HAS_BIAS = true;
    const float* b1; bf16* act;
    __device__ __forceinline__ void load_bias(f32x4 (&nb)[2][2], const Unit& u, int wc, int fq) const {
        const int e = u.pn >> 3, pnl = u.pn & 7; const float* bg = b1 + (size_t)e * 2048 + pnl * 128 + wc * 32 + 8 * fq;
        nb[0][0] = *(const f32x4*)bg; nb[0][1] = *(const f32x4*)(bg + 4); nb[1][0] = *(const f32x4*)(bg + 1024); nb[1][1] = *(const f32x4*)(bg + 1028); }
    __device__ __forceinline__ void operator()(AccT& acc, const Unit& u, int wr, int wc, int fr, int fq) const {
        const int pnl = u.pn & 7, row0 = u.pm * 256 + wr * 64 + fr, jc = pnl * 128 + wc * 32 + 8 * fq;
#pragma unroll
        for (int ai = 0; ai < 2; ++ai)
#pragma unroll
            for (int m = 0; m < 4; ++m) {
                const f32x4 g0 = acc[ai][0][m][0], g1 = acc[ai][0][m][1], u0 = acc[ai][1][m][0], u1 = acc[ai][1][m][1];
                float r[8];
#pragma unroll
                for (int h2 = 0; h2 < 4; ++h2) { const f32x4& gs = (h2 < 2) ? g0 : g1; const f32x4& us = (h2 < 2) ? u0 : u1; const int j0 = (h2 & 1) * 2;
                    f32x2 gv2 = (f32x2){fminf(gs[j0], 7.0f), fminf(gs[j0 + 1], 7.0f)};
                    f32x2 uv2 = (f32x2){__builtin_amdgcn_fmed3f(us[j0], -7.0f, 7.0f), __builtin_amdgcn_fmed3f(us[j0 + 1], -7.0f, 7.0f)};
                    const f32x2 t2 = gv2 * -2.4554669595930157f;
                    f32x2 e2; e2.x = __builtin_amdgcn_exp2f(t2.x); e2.y = __builtin_amdgcn_exp2f(t2.y);
                    const f32x2 d2 = e2 + 1.0f;
                    f32x2 s2; s2.x = frcp_(d2.x); s2.y = frcp_(d2.y);
                    const f32x2 o2 = ((uv2 + 1.0f) * gv2) * s2;
                    r[h2 * 2] = o2.x; r[h2 * 2 + 1] = o2.y; }
                u32x4 w; w.x = pg8::cvt_pk_bf16(r[0], r[1]); w.y = pg8::cvt_pk_bf16(r[2], r[3]); w.z = pg8::cvt_pk_bf16(r[4], r[5]); w.w = pg8::cvt_pk_bf16(r[6], r[7]);
                *(u32x4*)(act + (size_t)(row0 + ai * 128 + m * 16) * 1024 + jc) = w; }
    } };
struct EpiMoe2 { static constexpr bool PERM = true, HAS_BIAS = true;
    const float* b2; bf16* outk; int rowbase;
    __device__ __forceinline__ void load_bias(f32x4 (&nb)[2][2], const Unit& u, int wc, int fq) const {
        const int e = u.pn >> 2, pnl = u.pn & 3; const float* bp = b2 + (size_t)e * 1024 + pnl * 256 + wc * 32 + 8 * fq;
#pragma unroll
        for (int bj = 0; bj < 2; ++bj) { nb[bj][0] = *(const f32x4*)(bp + bj * 128); nb[bj][1] = *(const f32x4*)(bp + bj * 128 + 4); } }
    __device__ __forceinline__ void operator()(AccT& acc, const Unit& u, int wr, int wc, int fr, int fq) const {
        const int pnl = u.pn & 3, row0 = u.pm * 256 - rowbase + wr * 64 + fr, col0 = pnl * 256 + wc * 32 + 8 * fq;
#pragma unroll
        for (int ai = 0; ai < 2; ++ai)
#pragma unroll
            for (int m = 0; m < 4; ++m) { bf16* rowp = outk + (size_t)(row0 + ai * 128 + m * 16) * 1024 + col0;
#pragma unroll
                for (int bj = 0; bj < 2; ++bj) { const f32x4 v0 = acc[ai][bj][m][0], v1 = acc[ai][bj][m][1];
                    u32x4 o; o.x = pg8::cvt_pk_bf16(v0[0], v0[1]); o.y = pg8::cvt_pk_bf16(v0[2], v0[3]); o.z = pg8::cvt_pk_bf16(v1[0], v1[1]); o.w = pg8::cvt_pk_bf16(v1[2], v1[3]);
                    *(u32x4*)(rowp + bj * 128) = o; } }
    } };

__device__ __forceinline__ void p3_conv(const Args& a, const Frame& F) {
    const bf16* PQK = (const bf16*)(a.ws + WS_PQK); bf16* QKC = (bf16*)(a.ws + WS_QKC);
    const float* cw = a.in[IN_CONVW]; const float* cb = a.in[IN_CONVB];
    const int cg = F.tid & 127, sub = F.tid >> 7, c0 = cg * 8;
    float w0[8], w1[8], w2[8], bb[8];
#pragma unroll
    for (int j = 0; j < 8; ++j) { w0[j] = cw[c0 + j]; w1[j] = cw[1024 + c0 + j]; w2[j] = cw[2048 + c0 + j]; bb[j] = cb[c0 + j]; }
    const float scl = c0 < 512 ? 0.08838834764831845f : 1.0f;
    const u32x4 z = (u32x4){0u, 0u, 0u, 0u};
    for (int item = F.bid * 4 + sub; item < TA / 16; item += F.G * 4) {
        const int r0 = item * 16;
        const int len = (r0 < T) ? SEQ : CTXL, pos0 = (r0 < T) ? (r0 & (SEQ - 1)) : ((r0 - T) & (CTXL - 1));
        u32x4 rw[18];
#pragma unroll
        for (int i = 0; i < 18; ++i) { const int pos = pos0 + i - 1; rw[i] = (pos >= 0 && pos < len) ? *(const u32x4*)(PQK + (size_t)(r0 + i - 1) * 1024 + c0) : z; }
#pragma unroll
        for (int i = 0; i < 16; ++i) {
            const unsigned wm[4] = {rw[i].x, rw[i].y, rw[i].z, rw[i].w}, wc_[4] = {rw[i + 1].x, rw[i + 1].y, rw[i + 1].z, rw[i + 1].w}, wp[4] = {rw[i + 2].x, rw[i + 2].y, rw[i + 2].z, rw[i + 2].w};
            float o[8];
#pragma unroll
            for (int j = 0; j < 4; ++j) {
                const float a0 = bb[2 * j] + bflo(wm[j]) * w0[2 * j] + bflo(wc_[j]) * w1[2 * j] + bflo(wp[j]) * w2[2 * j];
                const float a1 = bb[2 * j + 1] + bfhi(wm[j]) * w0[2 * j + 1] + bfhi(wc_[j]) * w1[2 * j + 1] + bfhi(wp[j]) * w2[2 * j + 1];
                o[2 * j] = a0 * sigmoidf_(a0) * scl; o[2 * j + 1] = a1 * sigmoidf_(a1) * scl; }
            u32x4 w; w.x = pk2(o[0], o[1]); w.y = pk2(o[2], o[3]); w.z = pk2(o[4], o[5]); w.w = pk2(o[6], o[7]);
            *(u32x4*)(QKC + (size_t)(r0 + i) * 1024 + c0) = w;
        }
    }
    {
        const float* GT = (const float*)(a.ws + WS_GATES); float* GS = (float*)(a.ws + WS_GS); float* CH = (float*)(a.ws + WS_CHK);
        const int gw = F.bid * 8 + F.wave, NGW = F.G * 8, lane = F.lane;
        for (int it = gw; it < (TA / 128) * 8; it += NGW) {
            const int chunk = it >> 3, hd = it & 7, dir = hd >> 2, h = hd & 3, c0r = chunk * 128, t0 = 2 * lane;
            const int r0 = c0r + (dir ? 127 - t0 : t0), r1 = c0r + (dir ? 126 - t0 : t0 + 1);
            const int gi = (dir ? 8 : 0) + h, gf = (dir ? 12 : 4) + h; const float gbi = a.in[IN_GATEB][gi], gbf = a.in[IN_GATEB][gf];
            const float i0 = GT[(size_t)r0 * 16 + gi] + gbi, i1 = GT[(size_t)r1 * 16 + gi] + gbi, f0 = GT[(size_t)r0 * 16 + gf] + gbf, f1 = GT[(size_t)r1 * 16 + gf] + gbf;
            const float l0 = fminf(f0, 0.f) - __logf(1.0f + __expf(-fabsf(f0))), l1 = fminf(f1, 0.f) - __logf(1.0f + __expf(-fabsf(f1)));
            const float p1 = l0 + l1; float inc = p1;
#pragma unroll
            for (int o = 1; o < 64; o <<= 1) { const float t = __shfl_up(inc, o); if (lane >= o) inc += t; }
            const float exc = inc - p1, b0 = exc + l0, b1 = inc;
            const float g0 = i0 - b0, g1 = i1 - b1; float im = fmaxf(g0, g1);
#pragma unroll
            for (int o = 1; o < 64; o <<= 1) { const float t = __shfl_up(im, o); if (lane >= o) im = fmaxf(im, t); }
            float em = __shfl_up(im, 1); if (lane == 0) em = -INFINITY;
            GS[(size_t)hd * TA + r0] = g0; GS[(size_t)hd * TA + r1] = g1;
            GS[(size_t)(8 + hd) * TA + r0] = fmaxf(em, g0); GS[(size_t)(8 + hd) * TA + r1] = im;
            GS[(size_t)(16 + hd) * TA + r0] = b0; GS[(size_t)(16 + hd) * TA + r1] = b1;
            if (lane == 63) { CH[(hd * 528 + chunk) * 2] = inc; CH[(hd * 528 + chunk) * 2 + 1] = im; }
        }
    }
}

constexpr int SP = 272;
constexpr int S_QS = 0, S_K0 = 34816, S_K1 = 69632, S_VT = 104448, S_VA0 = 113424, S_VA1 = 122400, S_CT = 131376, S_GL = 144432, S_PM = 144944, S_BL = 145456;
__device__ __forceinline__ unsigned off_b(unsigned row, unsigned ch) { return 256u * row + 16u * (ch ^ (((row & 3u) << 2) | ((row >> 2) & 3u))); }
__device__ __forceinline__ bf16x8 mk_frag(u32x2 lo, u32x2 hi) { u32x4 v; v.x = lo.x; v.y = lo.y; v.z = hi.x; v.w = hi.y; return __builtin_bit_cast(bf16x8, v); }
__device__ __forceinline__ void tr_read_k8(u32x2 (&r)[8], const unsigned (&ad)[8]) {
    asm volatile(
        "ds_read_b64_tr_b16 %0, %8\n\tds_read_b64_tr_b16 %1, %9\n\tds_read_b64_tr_b16 %2, %10\n\tds_read_b64_tr_b16 %3, %11\n\t"
        "ds_read_b64_tr_b16 %4, %12\n\tds_read_b64_tr_b16 %5, %13\n\tds_read_b64_tr_b16 %6, %14\n\tds_read_b64_tr_b16 %7, %15\n\t"
        "s_waitcnt lgkmcnt(0)"
        : "=&v"(r[0]), "=&v"(r[1]), "=&v"(r[2]), "=&v"(r[3]), "=&v"(r[4]), "=&v"(r[5]), "=&v"(r[6]), "=&v"(r[7])
        : "v"(ad[0]), "v"(ad[1]), "v"(ad[2]), "v"(ad[3]), "v"(ad[4]), "v"(ad[5]), "v"(ad[6]), "v"(ad[7]) : "memory");
}
__device__ __forceinline__ void p4_scan(const Args& a, const Frame& F) {
    LAS unsigned char* L = F.lds;
    const bf16* QKC = (const bf16*)(a.ws + WS_QKC); const bf16* PV = (const bf16*)(a.ws + WS_PV);
    const float* GS = (const float*)(a.ws + WS_GS); const float* CH = (const float*)(a.ws + WS_CHK);
    const int tid = F.tid, lane = F.lane, w = F.wave, c = lane & 15, q = lane >> 4;
    LAS float* GL = (LAS float*)(L + S_GL); LAS float* PML = (LAS float*)(L + S_PM); LAS float* BL = (LAS float*)(L + S_BL);
    const unsigned Lb = (unsigned)(size_t)L;
    for (int blk = F.bid; blk < 256; blk += F.G) {
        const int xx = blk & 7, yy = blk >> 3, sub = yy & 7, bh = xx * 4 + (yy >> 3);
        const int vs = sub & 3, dir = sub >> 2, h = bh & 3, b = bh >> 2, hd = dir * 4 + h;
        bf16* HX = (bf16*)(a.ws + (dir ? WS_HB : WS_HF));
        __syncthreads();
        for (int i = tid; i < 128; i += 512) *(LAS bf16*)(L + S_VT + 32 * SP + i * 2) = (bf16)0x3F80;
        for (int i = tid; i < 48 * 136; i += 512) *(LAS bf16*)(L + S_CT + i * 2) = (bf16)0;
        auto chunk_base = [&](int ci) -> int { if (ci < 2) { const int cx = dir ? (1 - ci) : ci; return T + b * CTXL + cx * 128; } const int cx = dir ? (63 - (ci - 2)) : (ci - 2); return b * SEQ + cx * 128; };
        if (w >= 4) {
            int ht = tid - 256; asm volatile("" : "+v"(ht));
            u32x4 pq[8], pk[8], pv[2]; float pga[2], pgl[2], pbt = 0.f, ppx = 0.f, mcar = 0.f;
            pgl[0] = 0.f; pgl[1] = 0.f;
            auto prefetch = [&](int ci) {
                const int base = chunk_base(ci);
#pragma unroll
                for (int i = 0; i < 8; ++i) { const int p = ht + 256 * i, row = p >> 4, c16 = p & 15; const int tok = base + (dir ? 127 - row : row);
                    pq[i] = *(const u32x4*)(QKC + (size_t)tok * 1024 + h * 128 + c16 * 8); pk[i] = *(const u32x4*)(QKC + (size_t)tok * 1024 + 512 + h * 128 + c16 * 8); }
#pragma unroll
                for (int i = 0; i < 2; ++i) { const int p = ht + 256 * i, row = p >> 2, cc = p & 3; const int tok = base + (dir ? 127 - row : row);
                    pv[i] = *(const u32x4*)(PV + (size_t)tok * 512 + h * 128 + vs * 32 + cc * 8); pga[i] = GS[(size_t)hd * TA + tok]; }
#pragma unroll
                for (int i = 0; i < 2; ++i) { const int idx = ht + 256 * i; if (idx < 384) { const int row = idx & 127, arr = idx >> 7; const int tok = base + (dir ? 127 - row : row); pgl[i] = GS[(size_t)(arr * 8 + hd) * TA + tok]; } }
                pbt = CH[(hd * 528 + (base >> 7)) * 2]; ppx = CH[(hd * 528 + (base >> 7)) * 2 + 1];
            };
            auto commitK = [&](int kbuf) {
#pragma unroll
                for (int i = 0; i < 8; ++i) { const int p = ht + 256 * i, row = p >> 4, c16 = p & 15; *(LAS u32x4*)(L + kbuf + row * SP + c16 * 16) = pk[i]; } };
            auto commitQ = [&]() {
#pragma unroll
                for (int i = 0; i < 8; ++i) { const int p = ht + 256 * i, row = p >> 4, c16 = p & 15; *(LAS u32x4*)(L + S_QS + row * SP + c16 * 16) = pq[i]; } };
            auto commitV = [&](float mprev, int vabuf) {
#pragma unroll
                for (int i = 0; i < 2; ++i) { const int p = ht + 256 * i, row = p >> 2, cc = p & 3; const unsigned wv[4] = {pv[i].x, pv[i].y, pv[i].z, pv[i].w};
                    const float av = __expf(pga[i] - fmaxf(ppx, mprev));
#pragma unroll
                    for (int j = 0; j < 4; ++j) { const unsigned sc2 = pg8::cvt_pk_bf16(av * bflo(wv[j]), av * bfhi(wv[j]));
                        *(LAS bf16*)(L + S_VT + (cc * 8 + 2 * j) * SP + row * 2) = (bf16)(wv[j] & 0xffffu); *(LAS bf16*)(L + S_VT + (cc * 8 + 2 * j + 1) * SP + row * 2) = (bf16)(wv[j] >> 16);
                        *(LAS bf16*)(L + vabuf + (cc * 8 + 2 * j) * SP + row * 2) = (bf16)(sc2 & 0xffffu); *(LAS bf16*)(L + vabuf + (cc * 8 + 2 * j + 1) * SP + row * 2) = (bf16)(sc2 >> 16); }
                    if (cc == 0) *(LAS bf16*)(L + vabuf + 32 * SP + row * 2) = (bf16)f2bf(av); }
#pragma unroll
                for (int i = 0; i < 2; ++i) { const int idx = ht + 256 * i; if (idx < 384) { const int row = idx & 127, arr = idx >> 7; *(LAS float*)(L + S_GL + arr * 512 + row * 4) = pgl[i]; } }
            };
            prefetch(0);
            LDS_BARRIER();
            commitK(S_K0); commitQ(); commitV(0.f, S_VA0);
            float btot = pbt, pmx = ppx;
            LDS_BARRIER();
            const int lw = blk * 4 + (w - 4);
            float cv[32]; bf16* cD = nullptr; int ck0 = 0, crow = 0;
            auto conv_load = [&](int it) {
                const float* cW; int cN, cn;
                if (it < 32768) { const int e = it >> 10, sb = it & 1023; ck0 = (sb >> 6) * 64; cn = (sb & 63) * 32 + (lane & 31); cN = 2048; cW = a.in[IN_W1] + (size_t)e * 1024 * 2048; cD = (bf16*)(a.ws + WS_W1T);
                    const int up = cn >= 1024, nn = cn & 1023; crow = e * 2048 + (nn >> 7) * 256 + up * 128 + (nn & 127); }
                else { const int it2 = it - 32768, e = it2 >> 9, sb = it2 & 511; ck0 = (sb >> 5) * 64; cn = (sb & 31) * 32 + (lane & 31); cN = 1024; cW = a.in[IN_W2] + (size_t)e * 1024 * 1024; cD = (bf16*)(a.ws + WS_W2T); crow = e * 1024 + cn; }
#pragma unroll
                for (int i = 0; i < 32; ++i) cv[i] = cW[(size_t)(ck0 + (lane >> 5) + 2 * i) * cN + cn];
            };
            auto conv_store = [&]() {
                const bool hi = lane >= 32;
                u32x4 o[4];
#pragma unroll
                for (int i = 0; i < 16; ++i) { const float snd = hi ? cv[i] : cv[16 + i]; const float rcv = __shfl_xor(snd, 32);
                    const unsigned pkd = pg8::cvt_pk_bf16(hi ? rcv : cv[i], hi ? cv[16 + i] : rcv);
                    if ((i & 3) == 0) o[i >> 2].x = pkd; else if ((i & 3) == 1) o[i >> 2].y = pkd; else if ((i & 3) == 2) o[i >> 2].z = pkd; else o[i >> 2].w = pkd; }
                u32x4* dst = (u32x4*)(cD + (size_t)crow * 1024 + ck0 + (hi ? 32 : 0));
#pragma unroll
                for (int j2 = 0; j2 < 4; ++j2) dst[j2] = o[j2];
            };
            conv_load(lw);
            for (int ci = 0; ci < 66; ++ci) {
                const float M127 = fmaxf(pmx, mcar), mnew = btot + M127;
                const int cnx = ci + 1 < 66 ? ci + 1 : 65;
                prefetch(cnx);
                commitK((ci & 1) ? S_K0 : S_K1);
                if (ci < 48) conv_store();
                conv_load(lw + 1024 * ((ci + 1) % 48));
                LDS_BARRIER();
                mcar = mnew;
                commitQ(); commitV(mcar, (ci & 1) ? S_VA0 : S_VA1); btot = pbt; pmx = ppx;
                LDS_BARRIER();
            }
        } else {
            int c = lane & 15, q = lane >> 4; asm volatile("" : "+v"(c), "+v"(q));
            const int ta = w, tb = 7 - w, trA = 16 * ta + c, trB = 16 * tb + c;
            unsigned kadA[8];
#pragma unroll
            for (int ks = 0; ks < 4; ++ks)
#pragma unroll
                for (int t = 0; t < 2; ++t) kadA[ks * 2 + t] = (unsigned)((32 * ks + 8 * q + 4 * t + (c >> 2)) * SP + (4 * w + ((c & 3) >> 1)) * 16 + 8 * (c & 1));
            f32x4 accC[2][3];
#pragma unroll
            for (int d2 = 0; d2 < 2; ++d2)
#pragma unroll
                for (int i = 0; i < 3; ++i) accC[d2][i] = (f32x4){0.f, 0.f, 0.f, 0.f};
            float mcar = 0.f, pbt, ppx;
            { const int base0 = chunk_base(0); pbt = CH[(hd * 528 + (base0 >> 7)) * 2]; ppx = CH[(hd * 528 + (base0 >> 7)) * 2 + 1]; }
            LDS_BARRIER();
            float btot = pbt, pmx = ppx;
            LDS_BARRIER();
            const int npA = (ta + 2) >> 1, npB = (tb + 2) >> 1;
            for (int ci = 0; ci < 66; ++ci) {
                const int base = chunk_base(ci); const bool store = ci >= 2, more = ci + 1 < 66;
                const int kcur = (ci & 1) ? S_K1 : S_K0, vacur = (ci & 1) ? S_VA1 : S_VA0;
                const float M127 = fmaxf(pmx, mcar), cd = __expf(mcar - M127), mnew = btot + M127;
                if (more) { const int basen = chunk_base(ci + 1); pbt = CH[(hd * 528 + (basen >> 7)) * 2]; ppx = CH[(hd * 528 + (basen >> 7)) * 2 + 1]; }
                bf16x8 qfA[4], qfB[4];
                f32x4 acc3A[3], acc3B[3];
                {
                    bf16x8 cf[3][4];
#pragma unroll
                    for (int ks = 0; ks < 4; ++ks) { qfA[ks] = *(const LAS bf16x8*)(L + S_QS + trA * SP + (ks * 32 + q * 8) * 2); qfB[ks] = *(const LAS bf16x8*)(L + S_QS + trB * SP + (ks * 32 + q * 8) * 2); }
#pragma unroll
                    for (int mt = 0; mt < 3; ++mt)
#pragma unroll
                        for (int ks = 0; ks < 4; ++ks) cf[mt][ks] = *(const LAS bf16x8*)(L + S_CT + (16 * mt + c) * SP + (ks * 32 + q * 8) * 2);
                    LDS_WAIT(); __builtin_amdgcn_sched_barrier(0);
#pragma unroll
                    for (int mt = 0; mt < 3; ++mt) { acc3A[mt] = (f32x4){0.f, 0.f, 0.f, 0.f}; acc3B[mt] = (f32x4){0.f, 0.f, 0.f, 0.f};
#pragma unroll
                        for (int ks = 0; ks < 4; ++ks) { acc3A[mt] = __builtin_amdgcn_mfma_f32_16x16x32_bf16(cf[mt][ks], qfA[ks], acc3A[mt], 0, 0, 0); acc3B[mt] = __builtin_amdgcn_mfma_f32_16x16x32_bf16(cf[mt][ks], qfB[ks], acc3B[mt], 0, 0, 0); } }
                }
                const float MtA = fmaxf(PML[trA], mcar), MtB = fmaxf(PML[trB], mcar);
                const float decA = __expf(mcar - MtA), emtA = __expf(-(BL[trA] + MtA)), decB = __expf(mcar - MtB), emtB = __expf(-(BL[trB] + MtB));
                {
                    bf16x8 kf[2][4];
#pragma unroll
                    for (int u = 0; u < 2; ++u)
#pragma unroll
                        for (int ks = 0; ks < 4; ++ks) kf[u][ks] = *(const LAS bf16x8*)(L + kcur + (16 * u + c) * SP + (ks * 32 + q * 8) * 2);
                    for (int pr = 0; pr < npB; ++pr) {
                        LDS_WAIT(); __builtin_amdgcn_sched_barrier(0);
                        const bool doA = pr < npA;
                        f32x4 apA[2], apB[2], glv[2];
#pragma unroll
                        for (int u = 0; u < 2; ++u) glv[u] = *(const LAS f32x4*)(GL + 16 * (2 * pr + u) + 4 * q);
#pragma unroll
                        for (int u = 0; u < 2; ++u) { apA[u] = (f32x4){0.f, 0.f, 0.f, 0.f}; apB[u] = (f32x4){0.f, 0.f, 0.f, 0.f};
#pragma unroll
                            for (int ks = 0; ks < 4; ++ks) apB[u] = __builtin_amdgcn_mfma_f32_16x16x32_bf16(kf[u][ks], qfB[ks], apB[u], 0, 0, 0);
                            if (doA) {
#pragma unroll
                                for (int ks = 0; ks < 4; ++ks) apA[u] = __builtin_amdgcn_mfma_f32_16x16x32_bf16(kf[u][ks], qfA[ks], apA[u], 0, 0, 0); } }
                        __builtin_amdgcn_sched_barrier(0);
                        if (pr + 1 < npB) {
#pragma unroll
                            for (int u = 0; u < 2; ++u)
#pragma unroll
                                for (int ks = 0; ks < 4; ++ks) kf[u][ks] = *(const LAS bf16x8*)(L + kcur + (16 * (2 * pr + 2 + u) + c) * SP + (ks * 32 + q * 8) * 2);
                        }
#pragma unroll
                        for (int u = 0; u < 2; ++u) { const int s0 = 16 * (2 * pr + u) + 4 * q;
                            float r[4];
#pragma unroll
                            for (int j = 0; j < 4; ++j) r[j] = (s0 + j <= trB) ? apB[u][j] * __expf(glv[u][j] - MtB) : 0.f;
                            u32x2 o; o.x = pg8::cvt_pk_bf16(r[0], r[1]); o.y = pg8::cvt_pk_bf16(r[2], r[3]);
                            *(LAS u32x2*)(L + S_QS + trB * SP + s0 * 2) = o;
                            if (doA) {
#pragma unroll
                                for (int j = 0; j < 4; ++j) r[j] = (s0 + j <= trA) ? apA[u][j] * __expf(glv[u][j] - MtA) : 0.f;
                                o.x = pg8::cvt_pk_bf16(r[0], r[1]); o.y = pg8::cvt_pk_bf16(r[2], r[3]);
                                *(LAS u32x2*)(L + S_QS + trA * SP + s0 * 2) = o; } }
                    }
                }
                LDS_WAIT();
                f32x4 acc2A[3], acc2B[3];
#pragma unroll
                for (int mt = 0; mt < 3; ++mt) { acc2A[mt] = (f32x4){0.f, 0.f, 0.f, 0.f}; acc2B[mt] = (f32x4){0.f, 0.f, 0.f, 0.f}; }
                for (int ks = 0; ks < npB; ++ks) {
                    bf16x8 vf[3];
#pragma unroll
                    for (int mt = 0; mt < 3; ++mt) vf[mt] = *(const LAS bf16x8*)(L + S_VT + (16 * mt + c) * SP + (ks * 32 + q * 8) * 2);
                    const bf16x8 sB = *(const LAS bf16x8*)(L + S_QS + trB * SP + (ks * 32 + q * 8) * 2);
#pragma unroll
                    for (int mt = 0; mt < 3; ++mt) acc2B[mt] = __builtin_amdgcn_mfma_f32_16x16x32_bf16(vf[mt], sB, acc2B[mt], 0, 0, 0);
                    if (ks < npA) { const bf16x8 sA = *(const LAS bf16x8*)(L + S_QS + trA * SP + (ks * 32 + q * 8) * 2);
#pragma unroll
                        for (int mt = 0; mt < 3; ++mt) acc2A[mt] = __builtin_amdgcn_mfma_f32_16x16x32_bf16(vf[mt], sA, acc2A[mt], 0, 0, 0); }
                }
                {
                    const float denA = __shfl(acc2A[2][0] + decA * acc3A[2][0], c), denB = __shfl(acc2B[2][0] + decB * acc3B[2][0], c);
                    const float invA = frcp_(fmaxf(fabsf(denA), emtA)), invB = frcp_(fmaxf(fabsf(denB), emtB));
                    if (store) { const int tokA = base + (dir ? 127 - trA : trA), tokB = base + (dir ? 127 - trB : trB);
#pragma unroll
                        for (int mt = 0; mt < 2; ++mt) { const f32x4 vA = (acc2A[mt] + acc3A[mt] * decA) * invA, vB = (acc2B[mt] + acc3B[mt] * decB) * invB;
                            u32x2 o; o.x = pg8::cvt_pk_bf16(vA[0], vA[1]); o.y = pg8::cvt_pk_bf16(vA[2], vA[3]);
                            *(u32x2*)(HX + (size_t)tokA * 512 + h * 128 + vs * 32 + 16 * mt + 4 * q) = o;
                            o.x = pg8::cvt_pk_bf16(vB[0], vB[1]); o.y = pg8::cvt_pk_bf16(vB[2], vB[3]);
                            *(u32x2*)(HX + (size_t)tokB * 512 + h * 128 + vs * 32 + 16 * mt + 4 * q) = o; } }
                }
                LDS_BARRIER();
                {
                    bf16x8 vf[3][4];
#pragma unroll
                    for (int nt = 0; nt < 3; ++nt)
#pragma unroll
                        for (int ks = 0; ks < 4; ++ks) vf[nt][ks] = *(const LAS bf16x8*)(L + vacur + (16 * nt + c) * SP + (ks * 32 + q * 8) * 2);
#pragma unroll
                    for (int d2 = 0; d2 < 2; ++d2) {
                        unsigned ka[8];
#pragma unroll
                        for (int i = 0; i < 8; ++i) ka[i] = Lb + (unsigned)kcur + kadA[i] + (d2 ? 32u : 0u);
                        u32x2 kr[8]; tr_read_k8(kr, ka);
#pragma unroll
                        for (int nt = 0; nt < 3; ++nt) accC[d2][nt] = accC[d2][nt] * cd;
#pragma unroll
                        for (int ks = 0; ks < 4; ++ks) { const bf16x8 af = mk_frag(kr[ks * 2], kr[ks * 2 + 1]);
#pragma unroll
                            for (int nt = 0; nt < 3; ++nt) accC[d2][nt] = __builtin_amdgcn_mfma_f32_16x16x32_bf16(af, vf[nt][ks], accC[d2][nt], 0, 0, 0); }
#pragma unroll
                        for (int nt = 0; nt < 3; ++nt) { u32x2 o; o.x = pk2(accC[d2][nt][0], accC[d2][nt][1]); o.y = pk2(accC[d2][nt][2], accC[d2][nt][3]);
                            *(LAS u32x2*)(L + S_CT + (16 * nt + c) * SP + (16 * (2 * w + d2) + 4 * q) * 2) = o; }
                    }
                }
                mcar = mnew;
                if (more) { btot = pbt; pmx = ppx; }
                LDS_BARRIER();
            }
        }
    }
}

__device__ __forceinline__ void p5_pool_yb(const Args& a, const Frame& F) {
    const bf16* PP = (const bf16*)(a.ws + WS_PPOOL); bf16* PO_ = (bf16*)(a.ws + WS_POOLED);
    LAS unsigned char* L = F.lds;
    for (int item = F.bid; item < T / 64; item += F.G) {
        __syncthreads();
#pragma unroll
        for (int i = 0; i < 8; ++i) { const int p = F.tid + 512 * i, row = p >> 6, c16 = p & 63; *(LAS u32x4*)(L + row * 1024 + c16 * 16) = *(const u32x4*)(PP + (size_t)(item * 64 + row) * 512 + c16 * 8); }
        __syncthreads();
        const int cg = F.tid & 63, seg = F.tid >> 6, half = 1 << (cg >> 4), p0 = seg * 8;
        float sum[8];
#pragma unroll
        for (int j = 0; j < 8; ++j) sum[j] = 0.f;
        int lo = (p0 - half) > 0 ? (p0 - half) : 0, hi = (p0 + half) < 64 ? (p0 + half) : 64;
        for (int s2 = lo; s2 < hi; ++s2) { const u32x4 u = *(const LAS u32x4*)(L + s2 * 1024 + cg * 16);
            sum[0] += bflo(u.x); sum[1] += bfhi(u.x); sum[2] += bflo(u.y); sum[3] += bfhi(u.y); sum[4] += bflo(u.z); sum[5] += bfhi(u.z); sum[6] += bflo(u.w); sum[7] += bfhi(u.w); }
        for (int p = p0; p < p0 + 8; ++p) {
            const u32x4 u = *(const LAS u32x4*)(L + p * 1024 + cg * 16);
            const float ic = frcp_((float)(hi - lo));
            u32x4 o; o.x = pk2(sum[0] * ic - bflo(u.x), sum[1] * ic - bfhi(u.x)); o.y = pk2(sum[2] * ic - bflo(u.y), sum[3] * ic - bfhi(u.y));
            o.z = pk2(sum[4] * ic - bflo(u.z), sum[5] * ic - bfhi(u.z)); o.w = pk2(sum[6] * ic - bflo(u.w), sum[7] * ic - bfhi(u.w));
            *(u32x4*)(PO_ + (size_t)(item * 64 + p) * 512 + cg * 8) = o;
            const int nlo = (p + 1 - half) > 0 ? (p + 1 - half) : 0, nhi = (p + 1 + half) < 64 ? (p + 1 + half) : 64;
            if (nhi > hi) { const u32x4 v = *(const LAS u32x4*)(L + hi * 1024 + cg * 16);
                sum[0] += bflo(v.x); sum[1] += bfhi(v.x); sum[2] += bflo(v.y); sum[3] += bfhi(v.y); sum[4] += bflo(v.z); sum[5] += bfhi(v.z); sum[6] += bflo(v.w); sum[7] += bfhi(v.w); hi = nhi; }
            if (nlo > lo) { const u32x4 v = *(const LAS u32x4*)(L + lo * 1024 + cg * 16);
                sum[0] -= bflo(v.x); sum[1] -= bfhi(v.x); sum[2] -= bflo(v.y); sum[3] -= bfhi(v.y); sum[4] -= bflo(v.z); sum[5] -= bfhi(v.z); sum[6] -= bflo(v.w); sum[7] -= bfhi(v.w); lo = nlo; }
        }
    }
    const bf16* HF = (const bf16*)(a.ws + WS_HF); const bf16* HB = (const bf16*)(a.ws + WS_HB); const bf16* POg = (const bf16*)(a.ws + WS_PO); bf16* YB = (bf16*)(a.ws + WS_YB);
    const int gw = F.bid * 8 + F.wave, NGW = F.G * 8;
    const f32x4 hw0 = *(const f32x4*)(a.in[IN_HNW] + F.lane * 8), hw1 = *(const f32x4*)(a.in[IN_HNW] + F.lane * 8 + 4);
    const float hwv[8] = {hw0.x, hw0.y, hw0.z, hw0.w, hw1.x, hw1.y, hw1.z, hw1.w};
    for (int t0 = gw * 4; t0 < T; t0 += NGW * 4) {
        u32x4 f[4], bk[4], og[4];
#pragma unroll
        for (int u = 0; u < 4; ++u) { const size_t o = (size_t)(t0 + u) * 512 + F.lane * 8; f[u] = *(const u32x4*)(HF + o); bk[u] = *(const u32x4*)(HB + o); og[u] = *(const u32x4*)(POg + o); }
#pragma unroll
        for (int u = 0; u < 4; ++u) {
            float v[8];
            v[0] = bflo(f[u].x) + bflo(bk[u].x); v[1] = bfhi(f[u].x) + bfhi(bk[u].x); v[2] = bflo(f[u].y) + bflo(bk[u].y); v[3] = bfhi(f[u].y) + bfhi(bk[u].y);
            v[4] = bflo(f[u].z) + bflo(bk[u].z); v[5] = bfhi(f[u].z) + bfhi(bk[u].z); v[6] = bflo(f[u].w) + bflo(bk[u].w); v[7] = bfhi(f[u].w) + bfhi(bk[u].w);
            float s2 = 0.f;
#pragma unroll
            for (int jj = 0; jj < 8; ++jj) s2 += v[jj] * v[jj];
#pragma unroll
            for (int o = 1; o < 16; o <<= 1) s2 += __shfl_xor(s2, o);
            const float rstd = rsqrtf(s2 * (1.f / 128.f) + EPS);
            float gsig[8];
            gsig[0] = sigmoidf_(bflo(og[u].x)); gsig[1] = sigmoidf_(bfhi(og[u].x)); gsig[2] = sigmoidf_(bflo(og[u].y)); gsig[3] = sigmoidf_(bfhi(og[u].y));
            gsig[4] = sigmoidf_(bflo(og[u].z)); gsig[5] = sigmoidf_(bfhi(og[u].z)); gsig[6] = sigmoidf_(bflo(og[u].w)); gsig[7] = sigmoidf_(bfhi(og[u].w));
            float r[8];
#pragma unroll
            for (int jj = 0; jj < 8; ++jj) r[jj] = v[jj] * rstd * hwv[jj] * gsig[jj];
            u32x4 wv; wv.x = pg8::cvt_pk_bf16(r[0], r[1]); wv.y = pg8::cvt_pk_bf16(r[2], r[3]); wv.z = pg8::cvt_pk_bf16(r[4], r[5]); wv.w = pg8::cvt_pk_bf16(r[6], r[7]);
            *(u32x4*)(YB + (size_t)(t0 + u) * 512 + F.lane * 8) = wv;
        }
    }
}

__device__ __forceinline__ void moe_tables(const Args& a, const Frame& F) {
    LAS int* pst = (LAS int*)(F.misc + LM_PSTART); LAS unsigned char* tg = F.misc + LM_TILEG; LAS int* cxs = (LAS int*)(F.misc + LM_CX);
    LAS int* tmp = (LAS int*)F.lds; LAS int* Cpre = (LAS int*)(F.lds + 32768); LAS int* seg = (LAS int*)(F.lds + 65792);
    const int* cnt = (const int*)(a.ws + WS_CBASE);
    __syncthreads();
    for (int i = F.tid; i < 8192; i += 512) tmp[i] = cnt[i];
    if (F.tid == 0) cxs[0] = CX_MIN;
    __syncthreads();
    { const int e = F.tid & 31, sg = F.tid >> 5; int sacc = 0;
#pragma unroll
        for (int k = 0; k < 16; ++k) sacc += tmp[(sg * 16 + k) * 32 + e];
        seg[sg * 32 + e] = sacc; }
    __syncthreads();
    { const int e = F.tid & 31, sg = F.tid >> 5; int run = 0;
        for (int s2 = 0; s2 < sg; ++s2) run += seg[s2 * 32 + e];
#pragma unroll
        for (int k = 0; k < 16; ++k) { Cpre[(sg * 16 + k) * 32 + e] = run; run += tmp[(sg * 16 + k) * 32 + e]; }
        if (sg == 15) Cpre[256 * 32 + e] = run; }
    __syncthreads();
    if (F.tid >= CX_MIN && F.tid <= CX_MAX) { int tiles = 0;
        for (int e = 0; e < 32; ++e) tiles += (Cpre[F.tid * 32 + e] + 255) >> 8;
        if (tiles <= 512) atomicMax((int*)cxs, F.tid); }
    __syncthreads();
    if (F.tid == 0) { const int cx = cxs[0]; int acc = 0;
        for (int g = 0; g < NGRP; ++g) { pst[g] = acc; const int e = g & 31; const int c2 = g < 32 ? Cpre[cx * 32 + e] : Cpre[256 * 32 + e] - Cpre[cx * 32 + e]; acc += (c2 + 255) & ~255; }
        pst[NGRP] = acc; }
    __syncthreads();
    if (F.tid < NGRP) { const int t0 = pst[F.tid] >> 8, t1 = pst[F.tid + 1] >> 8; for (int t = t0; t < t1; ++t) tg[t] = (unsigned char)F.tid; }
    __syncthreads();
}

__device__ __forceinline__ void moe_tables_load(const Args& a, const Frame& F) {
    LAS int* pst = (LAS int*)(F.misc + LM_PSTART); LAS unsigned char* tg = F.misc + LM_TILEG; LAS int* cxs = (LAS int*)(F.misc + LM_CX);
    const int* tab = (const int*)(a.ws + WS_MOETAB);
    __syncthreads();
    if (F.tid < 65) pst[F.tid] = tab[F.tid];
    if (F.tid == 65) cxs[0] = tab[65];
    if (F.tid >= 128 && F.tid < 128 + 288) ((LAS int*)tg)[F.tid - 128] = tab[128 + F.tid - 128];
    __syncthreads();
}
__device__ __forceinline__ void p9_router(const Args& a, const Frame& F) {
    LAS unsigned char* Whi = F.lds; LAS unsigned char* Wlo = F.lds + 65536;
    LAS float* NWS = (LAS float*)(F.lds + 131072); LAS float* SHV = (LAS float*)(F.lds + 135168);
    LAS int* hist = (LAS int*)(F.lds + 139264);
    LAS float* red = (LAS float*)(F.lds + 139392);
    LAS f32x4* accb = (LAS f32x4*)(F.lds + 139904);
    const float* mod = (const float*)(a.ws + WS_MOD); bf16* H2 = (bf16*)(a.ws + WS_H2);
    int* cntg = (int*)(a.ws + WS_CBASE);
    int* ent_g = (int*)(a.ws + WS_ENT_G); int* ent_pos = (int*)(a.ws + WS_ENT_POS); float* ent_w = (float*)(a.ws + WS_ENT_W);
    const bf16* wr = (const bf16*)(a.ws + WS_WR_T);
    __syncthreads();
    for (int i = F.tid; i < 2 * 32 * 128; i += 512) { const int part = i >> 12, r = (i >> 7) & 31, c16 = i & 127;
        *(LAS u32x4*)((part ? Wlo : Whi) + r * 2048 + ((c16 ^ (r & 15)) << 4)) = *(const u32x4*)(wr + (size_t)part * 32768 + r * 1024 + c16 * 8); }
    const int c = F.lane & 15, q = F.lane >> 4, pair = F.wave >> 1;
    const float br0 = a.in[IN_BR][c], br1 = a.in[IN_BR][16 + c];
    for (int chunk = F.bid; chunk < T / 256; chunk += F.G) {
        const int bidx = (chunk * 256) >> 13;
        __syncthreads();
        if (F.tid < 32) hist[F.tid] = 0;
        for (int k = F.tid; k < 1024; k += 512) { NWS[k] = a.in[IN_N2W][k] * (1.0f + mod[bidx * 6144 + 4096 + k]); SHV[k] = mod[bidx * 6144 + 3072 + k]; }
        __syncthreads();
        for (int st = 0; st < 4; ++st) {
            const int tl0 = (st * 4 + pair) * 16, r = chunk * 256 + tl0 + c;
            f32x4 acc[2]; acc[0] = (f32x4){0.f, 0.f, 0.f, 0.f}; acc[1] = (f32x4){0.f, 0.f, 0.f, 0.f};
            norm_pair<2, true>(x1_row(a.out, a.ws, r), NWS, SHV, H2 + (size_t)r * D, Whi, Wlo, red, F.wave, c, q, acc);
            if (F.wave & 1) accb[pair * 64 + F.lane] = acc[0];
            LDS_BARRIER();
            if (!(F.wave & 1)) acc[0] += accb[pair * 64 + F.lane];
            LDS_BARRIER();
            if (F.wave & 1) accb[pair * 64 + F.lane] = acc[1];
            LDS_BARRIER();
            if (!(F.wave & 1)) {
                acc[1] += accb[pair * 64 + F.lane];
#pragma unroll
                for (int j = 0; j < 4; ++j) {
                    float v0 = acc[0][j] + br0, v1 = acc[1][j] + br1;
                    float tv[4]; int ti[4];
#pragma unroll
                    for (int k = 0; k < 4; ++k) {
                        float bv; int bi; if (v1 > v0) { bv = v1; bi = 16 + c; } else { bv = v0; bi = c; }
#pragma unroll
                        for (int o = 1; o < 16; o <<= 1) { const float ov = __shfl_xor(bv, o); const int oi = __shfl_xor(bi, o); if (ov > bv || (ov == bv && oi < bi)) { bv = ov; bi = oi; } }
                        tv[k] = bv; ti[k] = bi; if (bi == c) v0 = -INFINITY; if (bi == 16 + c) v1 = -INFINITY;
                    }
                    const float e1 = __expf(tv[1] - tv[0]), e2 = __expf(tv[2] - tv[0]), e3 = __expf(tv[3] - tv[0]); const float inv = 1.0f / (1.0f + e1 + e2 + e3);
                    if (c < 4) { const int e = c == 0 ? ti[0] : c == 1 ? ti[1] : c == 2 ? ti[2] : ti[3]; const float wgt = (c == 0 ? 1.0f : c == 1 ? e1 : c == 2 ? e2 : e3) * inv;
                        const int lp = atomicAdd((int*)(hist + e), 1);
                        const size_t gi = (size_t)(chunk * 256 + tl0 + 4 * q + j) * 4 + c; ent_g[gi] = e; ent_pos[gi] = lp; ent_w[gi] = wgt; }
                }
            }
        }
        __syncthreads();
        if (F.tid < 32) cntg[chunk * 32 + F.tid] = hist[F.tid];
    }
}

__device__ __forceinline__ void p10_scatter(const Args& a, const Frame& F) {
    moe_tables(a, F);
    LAS int* pst = (LAS int*)(F.misc + LM_PSTART); const LAS int* Cpre = (const LAS int*)(F.lds + 32768);
    const int cx = ((const LAS int*)(F.misc + LM_CX))[0];
    if (F.bid == 0) { int* tab = (int*)(a.ws + WS_MOETAB);
        if (F.tid < 65) tab[F.tid] = pst[F.tid];
        if (F.tid == 65) tab[65] = cx;
        if (F.tid >= 128 && F.tid < 128 + 288) tab[128 + F.tid - 128] = ((const LAS int*)(F.misc + LM_TILEG))[F.tid - 128]; }
    const int* ent_g = (const int*)(a.ws + WS_ENT_G); const int* ent_pos = (const int*)(a.ws + WS_ENT_POS);
    int* row_tok = (int*)(a.ws + WS_ROW_TOK); int* tok_row = (int*)(a.ws + WS_TOK_ROW);
    for (int idx = F.bid * 512 + F.tid; idx < T * 4; idx += F.G * 512) {
        const int e = ent_g[idx], chunk = idx >> 10, part = chunk >= cx ? 1 : 0, t = idx >> 2;
        const int r = pst[part * 32 + e] + Cpre[chunk * 32 + e] - (part ? Cpre[cx * 32 + e] : 0) + ent_pos[idx];
        row_tok[r] = t; tok_row[idx] = r;
    }
    for (int g = F.bid; g < NGRP; g += F.G) { const int e = g & 31; const int c2 = g < 32 ? Cpre[cx * 32 + e] : Cpre[256 * 32 + e] - Cpre[cx * 32 + e]; const int r0 = pst[g] + c2, r1 = pst[g + 1];
        for (int r = r0 + F.tid; r < r1; r += 512) row_tok[r] = 0; }
}

__device__ __forceinline__ void p_final(const Args& a, const Frame& F, int half) {
    moe_tables_load(a, F);
    const int rowbase = half ? ((const LAS int*)(F.misc + LM_PSTART))[32] : 0;
    const int X = 256 * ((const LAS int*)(F.misc + LM_CX))[0], tbeg = half ? X : 0, tend = half ? T : X;
    const float* mod = (const float*)(a.ws + WS_MOD); const bf16* OUTK = (const bf16*)(a.ws + WS_OUTK);
    const int* tok_row = (const int*)(a.ws + WS_TOK_ROW); const float* ent_w = (const float*)(a.ws + WS_ENT_W);
    const int gw = F.bid * 8 + F.wave, NGW = F.G * 8;
    const f32x4* fw = (const f32x4*)a.in[IN_FNW] + F.lane;
    int rkn[4]; float wkn[4];
    { const int t0 = tbeg + gw; if (t0 < tend) {
#pragma unroll
        for (int k = 0; k < 4; ++k) { rkn[k] = tok_row[t0 * 4 + k] - rowbase; wkn[k] = ent_w[t0 * 4 + k]; } } }
    for (int t = tbeg + gw; t < tend; t += NGW) {
        f32x4* xr = (f32x4*)(a.out + (size_t)t * D) + F.lane;
        const u32x2* x1p = (const u32x2*)x1_row(a.out, a.ws, t) + F.lane;
        const f32x4* g2 = (const f32x4*)(mod + (t >> 13) * 6144 + 5120) + F.lane;
        int rk[4]; float wk[4];
#pragma unroll
        for (int k = 0; k < 4; ++k) { rk[k] = rkn[k]; wk[k] = wkn[k]; }
        u32x2 ok[4][4], xw[4];
#pragma unroll
        for (int j = 0; j < 4; ++j) { xw[j] = x1p[64 * j];
#pragma unroll
            for (int k = 0; k < 4; ++k) ok[j][k] = *((const u32x2*)(OUTK + (size_t)rk[k] * D) + F.lane + 64 * j); }
        { const int tn = t + NGW; if (tn < tend) {
#pragma unroll
            for (int k = 0; k < 4; ++k) { rkn[k] = tok_row[tn * 4 + k] - rowbase; wkn[k] = ent_w[tn * 4 + k]; } } }
        f32x4 v[4]; float s = 0.f;
#pragma unroll
        for (int j = 0; j < 4; ++j) {
            f32x4 m = (f32x4){0.f, 0.f, 0.f, 0.f};
#pragma unroll
            for (int k = 0; k < 4; ++k) { const u32x2 o = ok[j][k]; m.x += wk[k] * bflo(o.x); m.y += wk[k] * bfhi(o.x); m.z += wk[k] * bflo(o.y); m.w += wk[k] * bfhi(o.y); }
            v[j] = (f32x4){bflo(xw[j].x), bfhi(xw[j].x), bflo(xw[j].y), bfhi(xw[j].y)} + g2[64 * j] * m;
            s += (v[j].x * v[j].x + v[j].y * v[j].y) + (v[j].z * v[j].z + v[j].w * v[j].w);
        }
        const float rstd = rsqrtf(wave_sum(s) * (1.f / D) + EPS);
#pragma unroll
        for (int j = 0; j < 4; ++j) xr[64 * j] = v[j] * rstd * fw[64 * j];
    }
}

__global__ void __launch_bounds__(512, 2) mk_fwd(Args args) {
    extern __shared__ __attribute__((aligned(16))) unsigned char lds_raw[];
    Frame F;
    F.lds = (LAS unsigned char*)lds_raw; F.misc = F.lds + LDS_MAIN;
    F.tid = threadIdx.x; F.lane = F.tid & 63; F.wave = __builtin_amdgcn_readfirstlane(F.tid >> 6); F.G = gridDim.x; F.bid = blockIdx.x;
    unsigned char* ws = args.ws;
    const int lo = args.ph_lo, hi = args.ph_hi;
    if (F.tid < 4) ((LAS unsigned*)(F.misc + LM_BAR))[F.tid] = 0u;
    __syncthreads();
    XcdBarrier bar; bar.bar = (unsigned*)(ws + WS_CTL) + CW_BAR; bar.x = 0; bar.st = nullptr;
    if (hi - lo > 1) bar = xcd_barrier_post((unsigned*)(ws + WS_CTL) + CW_BAR, (volatile LAS unsigned*)(F.misc + LM_BAR));
#define IN(k) (lo <= (k) && (k) < hi)
#define SEAM(k) do { if (IN(k) && IN((k) + 1)) xcd_barrier(bar); } while (0)

    if (IN(0)) { p0_prologue(args, F); } SEAM(0);
    if (IN(1)) { p1_xn(args, F); } SEAM(1);
    if (IN(2)) {
        pg8::Gemm g{(const bf16*)(ws + WS_XN), (const bf16*)(ws + WS_WIN_T), 1024, nullptr, nullptr, nullptr};
        SchedIn S{F.G, F.bid};
        EpiIn E{(bf16*)(ws + WS_PPOOL), (bf16*)(ws + WS_PQK), (bf16*)(ws + WS_PV), (bf16*)(ws + WS_PO), ws + WS_PMERGE};
        pg8::gemm_phase<EpiIn, SchedIn, false>(F.lds, g, S, E);
    } SEAM(2);
    if (IN(3)) { p3_conv(args, F); } SEAM(3);
    if (IN(4)) { p4_scan(args, F); } SEAM(4);
    if (IN(5)) { p5_pool_yb(args, F); } SEAM(5);
    if (IN(6)) {
        pg8::Gemm g{(const bf16*)(ws + WS_POOLED), (const bf16*)(ws + WS_WPA_T), 512, nullptr, (const bf16*)(ws + WS_YB), (const bf16*)(ws + WS_WBM_T)};
        SchedMerge S{F.G, F.bid};
        EpiMerge E{(const unsigned char*)(ws + WS_PMERGE), (bf16*)(ws + WS_Y)};
        pg8::gemm_phase<EpiMerge, SchedMerge, false, true>(F.lds, g, S, E);
    } SEAM(6);
    if (IN(8)) {
        pg8::Gemm g{(const bf16*)(ws + WS_Y), (const bf16*)(ws + WS_WOUT_T), 1024, nullptr, nullptr, nullptr};
        pg8::StaticOrder S{256, 4, F.G, F.bid};
        EpiOut E{args.in[IN_X], (const float*)(ws + WS_MOD), args.out, ws};
        pg8::gemm_phase<EpiOut, pg8::StaticOrder, false>(F.lds, g, S, E);
    } SEAM(8);
    if (IN(9)) { p9_router(args, F); } SEAM(9);
    if (IN(10)) { p10_scatter(args, F); } SEAM(10);
    if (IN(11)) {
        moe_tables_load(args, F);
        const LAS int* pst = (const LAS int*)(F.misc + LM_PSTART);
        pg8::Gemm g{(const bf16*)(ws + WS_H2), (const bf16*)(ws + WS_W1T), 1024, (const int*)(ws + WS_ROW_TOK), nullptr, nullptr};
        SchedMoe S{F.G, F.bid, 8, 0, pst[NGRP] >> 8, (const LAS unsigned char*)(F.misc + LM_TILEG)};
        EpiMoe1 E{args.in[IN_B1], (bf16*)(ws + WS_ACT)};
        pg8::gemm_phase<EpiMoe1, SchedMoe, true>(F.lds, g, S, E);
    } SEAM(11);
    if (IN(12)) {
        moe_tables_load(args, F);
        const LAS int* pst = (const LAS int*)(F.misc + LM_PSTART);
        pg8::Gemm g{(const bf16*)(ws + WS_ACT), (const bf16*)(ws + WS_W2T), 1024, nullptr, nullptr, nullptr};
        SchedMoe S{F.G, F.bid, 4, 0, pst[32] >> 8, (const LAS unsigned char*)(F.misc + LM_TILEG)};
        EpiMoe2 E{args.in[IN_B2], (bf16*)(ws + WS_OUTK), 0};
        pg8::gemm_phase<EpiMoe2, SchedMoe, false>(F.lds, g, S, E);
    } SEAM(12);
    if (IN(13)) { p_final(args, F, 0); } SEAM(13);
    if (IN(14)) {
        moe_tables_load(args, F);
        const LAS int* pst = (const LAS int*)(F.misc + LM_PSTART);
        pg8::Gemm g{(const bf16*)(ws + WS_ACT), (const bf16*)(ws + WS_W2T), 1024, nullptr, nullptr, nullptr};
        SchedMoe S{F.G, F.bid, 4, pst[32] >> 8, pst[NGRP] >> 8, (const LAS unsigned char*)(F.misc + LM_TILEG)};
        EpiMoe2 E{args.in[IN_B2], (bf16*)(ws + WS_OUTK), pst[32]};
        pg8::gemm_phase<EpiMoe2, SchedMoe, false>(F.lds, g, S, E);
    } SEAM(14);
    if (IN(15)) { p_final(args, F, 1); }
#undef IN
#undef SEAM
}

extern "C" void kernel_launch(void* const* d_in, const int* in_sizes, int n_in, void* d_out, int out_size, void* d_ws, size_t ws_size, hipStream_t stream) {
    static int grid = 0;
    if (grid == 0) {
        if (n_in != 25 || out_size != T * D || ws_size < WS_END) { fprintf(stderr, "kernel_launch: unexpected shapes (n_in %d out %d ws %zu)\n", n_in, out_size, ws_size); grid = -1; return; }
        int dev = 0, cus = 0, per_cu = 0;
        if (hipGetDevice(&dev) != hipSuccess || hipDeviceGetAttribute(&cus, hipDeviceAttributeMultiprocessorCount, dev) != hipSuccess) { grid = -1; return; }
        if (hipFuncSetAttribute((const void*)mk_fwd, hipFuncAttributeMaxDynamicSharedMemorySize, LDS_BYTES) != hipSuccess) { fprintf(stderr, "kernel_launch: hipFuncSetAttribute failed\n"); grid = -1; return; }
        if (hipOccupancyMaxActiveBlocksPerMultiprocessor(&per_cu, (const void*)mk_fwd, 512, LDS_BYTES) != hipSuccess || per_cu < 1) fprintf(stderr, "kernel_launch: occupancy query says %d\n", per_cu);
        (void)hipGetLastError();
        grid = cus;
    }
    if (grid < 0) return;
    (void)hipMemsetAsync((char*)d_ws + WS_CTL, 0, CTL_BYTES, stream);
    Args a{};
    for (int i = 0; i < 25; ++i) a.in[i] = (const float*)d_in[i];
    a.out = (float*)d_out; a.ws = (unsigned char*)d_ws;
#if MK_MULTI
    for (int p = 0; p < NPHASE; ++p) { a.ph_lo = p; a.ph_hi = p + 1; hipLaunchKernelGGL(mk_fwd, dim3(grid), dim3(512), LDS_BYTES, stream, a); }
#else
    a.ph_lo = 0; a.ph_hi = NPHASE;
    hipLaunchKernelGGL(mk_fwd, dim3(grid), dim3(512), LDS_BYTES, stream, a);
#endif
}
```

```cpp
#include <hip/hip_runtime.h>
#include <cstdio>
#include <cstdint>

#ifndef MK_MULTI
#define MK_MULTI 0
#endif

#define LAS __attribute__((address_space(3)))
#define GAS __attribute__((address_space(1)))
typedef unsigned short bf16;
typedef short bf16x8 __attribute__((ext_vector_type(8)));
typedef float f32x4 __attribute__((ext_vector_type(4)));
typedef float f32x2 __attribute__((ext_vector_type(2)));
typedef unsigned u32x4 __attribute__((ext_vector_type(4)));
typedef unsigned u32x2 __attribute__((ext_vector_type(2)));

constexpr int D = 1024, NBATCH = 8, SEQ = 8192, T = NBATCH * SEQ, CTXL = 256, TCX = NBATCH * CTXL, TA = T + TCX;
constexpr int INW = 4624;
constexpr int NEXP = 32, NGRP = 64;
constexpr int XSPLIT = 30720;
constexpr int CX_MIN = 121, CX_MAX = 128;
constexpr int MAXROWS = T * 4 + NGRP * 256;
constexpr int NPHASE = 16;
constexpr float EPS = 1e-6f;

constexpr size_t MiB = 1u << 20;
constexpr size_t WS_CTL = 0, CTL_BYTES = 1 * MiB;
constexpr size_t WS_MOD = 1 * MiB;
constexpr size_t WS_ENT_G = 2 * MiB, WS_ENT_POS = 3 * MiB, WS_ENT_W = 4 * MiB;
constexpr size_t WS_ROW_TOK = 5 * MiB;
constexpr size_t WS_TOK_ROW = 9 * MiB;
constexpr size_t WS_CBASE = 6 * MiB + 512 * 1024;
constexpr size_t WS_MOETAB = 10 * MiB + 512 * 1024;
constexpr size_t WS_GATES = 11 * MiB;
constexpr size_t WS_WIN_T = 16 * MiB;
constexpr size_t WS_WPA_T = 26 * MiB, WS_WBM_T = 27 * MiB, WS_WOUT_T = 28 * MiB;
constexpr size_t WS_WG_T = 30 * MiB;
constexpr size_t WS_WR_T = 31 * MiB;
constexpr size_t WS_GS = 32 * MiB;
constexpr size_t WS_CHK = 39 * MiB;
constexpr size_t WS_XN = 40 * MiB;
constexpr size_t WS_QKC = 40 * MiB, WS_POOLED = 40 * MiB, WS_YB = 104 * MiB;
constexpr size_t WS_PQK = 172 * MiB;
constexpr size_t WS_HF = 172 * MiB, WS_HB = 236 * MiB, WS_Y = 172 * MiB;
constexpr size_t WS_PPOOL = 304 * MiB, WS_PV = 368 * MiB, WS_PO = 434 * MiB, WS_PMERGE = 498 * MiB;
constexpr size_t WS_W1T = 754 * MiB, WS_W2T = 882 * MiB;
constexpr size_t WS_ACT = 40 * MiB, WS_H2 = 626 * MiB, WS_OUTK = 585 * MiB;
constexpr size_t WS_X1B = 946 * MiB;
constexpr size_t WS_END = 1014 * MiB;
static_assert((size_t)MAXROWS * 2048 <= (626 - 40) * MiB, "ACT fits");
constexpr int CW_BAR = 4096;
constexpr int CW_GCNT = 16384;

constexpr int LDS_MAIN = 131072, LDS_BYTES = 147456;
constexpr int LM_BAR = 16368, LM_PSTART = 8704, LM_CX = 8704 + 272, LM_TILEG = 9216;

__device__ __forceinline__ unsigned f2bf(float f) { unsigned u = __builtin_bit_cast(unsigned, f); return (u + 0x7fffu + ((u >> 16) & 1u)) >> 16; }
__device__ __forceinline__ unsigned pk2(float lo, float hi) { return f2bf(lo) | (f2bf(hi) << 16); }
__device__ __forceinline__ float bflo(unsigned w) { return __uint_as_float(w << 16); }
__device__ __forceinline__ float bfhi(unsigned w) { return __uint_as_float(w & 0xffff0000u); }
__device__ __forceinline__ float bf2f(bf16 h) { return __uint_as_float(((unsigned)h) << 16); }
__device__ __forceinline__ float fexp_(float x) { return __builtin_amdgcn_exp2f(x * 1.4426950408889634f); }
__device__ __forceinline__ float frcp_(float x) { return __builtin_amdgcn_rcpf(x); }
__device__ __forceinline__ float sigmoidf_(float x) { return frcp_(1.0f + fexp_(-x)); }
__device__ __forceinline__ float wave_sum(float v) {
#pragma unroll
    for (int o = 1; o < 64; o <<= 1) v += __shfl_xor(v, o);
    return v;
}
#define LDS_WAIT() asm volatile("s_waitcnt lgkmcnt(0)" ::: "memory")
#define VM_WAIT() asm volatile("s_waitcnt vmcnt(0)" ::: "memory")
#define LDS_BARRIER() do { asm volatile("s_waitcnt lgkmcnt(0)" ::: "memory"); __builtin_amdgcn_s_barrier(); asm volatile("" ::: "memory"); } while (0)

#define XB_TMO      128
#define XB_XCNT(j)  (256  + 64 * (j))
#define XB_XSUB(j)  (1280 + 64 * (j))
#define XB_XGEN(j)  (2304 + 64 * (j))
#define XB_TOP      3328
#define XB_TOPGEN   3392
#define XCD_BAR_WORDS 3456
#define XB_SPIN_CAP (1u << 18)
__device__ __forceinline__ unsigned xb_ld(unsigned* p)              { return __hip_atomic_load(p, __ATOMIC_RELAXED, __HIP_MEMORY_SCOPE_AGENT); }
__device__ __forceinline__ unsigned xb_add(unsigned* p, unsigned v) { return __hip_atomic_fetch_add(p, v, __ATOMIC_RELAXED, __HIP_MEMORY_SCOPE_AGENT); }
__device__ __forceinline__ unsigned xb_xcc_id() { return (unsigned)__builtin_amdgcn_s_getreg((3 << 11) | 20) & 0xFu; }
#define XB_SPIN(cond, bar) do { unsigned _sp = 0; while (cond) { __builtin_amdgcn_s_sleep(1); \
    if ((++_sp & 255u) == 0u) { if (xb_ld(&(bar)[XB_TMO])) break; if (_sp > XB_SPIN_CAP) { atomicAdd(&(bar)[XB_TMO], 1u); break; } } } } while (0)
struct XcdBarrier { unsigned* bar; unsigned x; volatile LAS unsigned* st; };
__device__ __forceinline__ XcdBarrier xcd_barrier_post(unsigned* bar, volatile LAS unsigned* st) {
    XcdBarrier b; b.bar = bar; b.x = xb_xcc_id(); b.st = st;
    if (threadIdx.x == 0) (void)xb_add(&bar[XB_XCNT(b.x)], 1u);
    return b;
}
__device__ __forceinline__ void xcd_barrier_complete(unsigned* bar, unsigned x, unsigned& nloc, unsigned& nx) {
    const unsigned G = gridDim.x * gridDim.y * gridDim.z;
    unsigned sum, cnt, mine, sp = 0u;
    for (;;) {
        sum = 0u; cnt = 0u; mine = 0u;
#pragma unroll
        for (unsigned j = 0; j < 16; ++j) { const unsigned c = xb_ld(&bar[XB_XCNT(j)]); sum += c; cnt += (c > 0u) ? 1u : 0u; mine = (j == x) ? c : mine; }
        if (sum == G) break;
        __builtin_amdgcn_s_sleep(1);
        if ((++sp & 255u) == 0u) { if (xb_ld(&bar[XB_TMO])) break; if (sp > XB_SPIN_CAP) { atomicAdd(&bar[XB_TMO], 1u); break; } }
    }
    nloc = mine > 0u ? mine : 1u; nx = cnt > 0u ? cnt : 1u;
}
__device__ __forceinline__ void xcd_barrier(const XcdBarrier& b) {
    asm volatile("s_waitcnt vmcnt(0)" ::: "memory");
    __syncthreads();
    if (threadIdx.x == 0) {
        unsigned* bar = b.bar;
        __builtin_amdgcn_s_waitcnt(0);
        unsigned nloc = b.st[0], nx = b.st[1];
        if (nloc == 0u) { xcd_barrier_complete(bar, b.x, nloc, nx); b.st[0] = nloc; b.st[1] = nx; }
        const unsigned old = xb_add(&bar[XB_XSUB(b.x)], 1u);
        const unsigned gen = old / nloc;
        if (old + 1u == (gen + 1u) * nloc) {
            __builtin_amdgcn_fence(__ATOMIC_RELEASE, "agent");
            asm volatile("s_waitcnt vmcnt(0)" ::: "memory");
            const unsigned og = xb_add(&bar[XB_TOP], 1u);
            const unsigned tg = og / nx;
            if (og + 1u == (tg + 1u) * nx) xb_add(&bar[XB_TOPGEN], 1u);
            else XB_SPIN(xb_ld(&bar[XB_TOPGEN]) == tg, bar);
            __builtin_amdgcn_fence(__ATOMIC_ACQUIRE, "agent");
            xb_add(&bar[XB_XGEN(b.x)], 1u);
            asm volatile("s_waitcnt vmcnt(0)" ::: "memory");
        } else {
            XB_SPIN(xb_ld(&bar[XB_XGEN(b.x)]) == gen, bar);
            __builtin_amdgcn_fence(__ATOMIC_ACQUIRE, "agent");
            asm volatile("s_waitcnt vmcnt(0)" ::: "memory");
        }
    }
    __syncthreads();
}

namespace pg8 {
constexpr int BM = 256, BK = 64, HALF = 128, HTB = HALF * BK * 2, STAGE_BYTES = 8 * HTB;
__device__ __forceinline__ int lds_byte(int r, int c) { const int st = (r >> 4) * 2 + (c >> 5), rr = r & 15, cc = c & 31, ob = rr * 64 + cc * 2; return st * 1024 + (ob ^ (((ob >> 9) & 1) << 5)); }
__device__ __forceinline__ void stage_rc(int b, int& R, int& C) { const int st = b / 1024, sb = b % 1024, swz = sb ^ (((sb >> 9) & 1) << 5); R = (st >> 1) * 16 + swz / 64; C = (st & 1) * 32 + (swz % 64) / 2; }
__device__ __forceinline__ int perm32(int rho) { const int n = rho >> 4, i = rho & 15; return 8 * (i >> 2) + 4 * n + (i & 3); }
struct Unit { int pm, pn; };
struct Gemm { const bf16* A; const bf16* Bt; int K; const int* rowidx; const bf16* A2; const bf16* Bt2; };

__device__ __forceinline__ void static_unit(int wgid, int nM, int nN, Unit& u) {
    const int nwg = nM * nN;
    { const int q = nwg / 8, r = nwg % 8, xcd = wgid % 8, off = wgid / 8; wgid = (xcd < r ? xcd * (q + 1) : r * (q + 1) + (xcd - r) * q) + off; }
    const int nig = 8 * nN, gid = wgid / nig, fm = gid * 8, gsz = (nM - fm) < 8 ? (nM - fm) : 8;
    u.pm = fm + ((wgid % nig) % gsz); u.pn = (wgid % nig) / gsz;
}
struct StaticOrder { int nM, nN, G, c;
    __device__ __forceinline__ bool next(int i, Unit& u) const { const long L = (long)i * G + c; if (L >= (long)nM * nN) return false; static_unit((int)L, nM, nN, u); return true; } };

__device__ __forceinline__ unsigned cvt_pk_bf16(float lo, float hi) { unsigned r; asm volatile("v_cvt_pk_bf16_f32 %0, %1, %2" : "=v"(r) : "v"(lo), "v"(hi)); return r; }

template <class Epi, class Sched, bool GATHER, bool DUAL = false>
__device__ __forceinline__ void gemm_phase(LAS unsigned char* lds, const Gemm g, const Sched& S, const Epi& E) {
    const int tid = threadIdx.x, wid = __builtin_amdgcn_readfirstlane(tid >> 6), lane = tid & 63, wr = wid >> 2, wc = wid & 3, fr = lane & 15, fq = lane >> 4;
    const int K = g.K, nt = K / BK;
    int sR[2], sC[2]; unsigned voffB[2];
#pragma unroll
    for (int i = 0; i < 2; ++i) { int R, C; stage_rc(tid * 16 + i * 8192, R, C); sR[i] = R; sC[i] = C; const int Rb = Epi::PERM ? ((R & ~31) + perm32(R & 31)) : R; voffB[i] = (unsigned)(Rb * K + C) * 2u; }
    const size_t kstep = (size_t)(BK * 2);
    const size_t hstep = (size_t)HALF * K * 2;
    const size_t tstep = 2 * hstep;
    const unsigned ldsw = (unsigned)wid * 1024u;
    const int aoff = lds_byte(wr * 64 + fr, fq * 8), boff = lds_byte(wc * 32 + fr, fq * 8);
#define PG8_SA(b, h) (((b) * 2 + (h)) * HTB)
#define PG8_SB(b, h) ((4 + (b) * 2 + (h)) * HTB)
#define PG8_STAGE(bufoff, gbase, voff) do { _Pragma("unroll") for (int _i = 0; _i < 2; ++_i) \
        __builtin_amdgcn_global_load_lds((const unsigned*)((const char*)(gbase) + (voff)[_i]), (LAS unsigned*)(lds + (bufoff) + ldsw + _i * 8192), 16, 0, 0); } while (0)
#define PG8_STAGEA(bufoff, ab, kb, ofs) do { _Pragma("unroll") for (int _i = 0; _i < 2; ++_i) \
        __builtin_amdgcn_global_load_lds((const unsigned*)((ab) + (kb) + (ofs)[_i]), (LAS unsigned*)(lds + (bufoff) + ldsw + _i * 8192), 16, 0, 0); } while (0)
#define PG8_LDA(dst, b, h) do { _Pragma("unroll") for (int m = 0; m < 4; ++m) _Pragma("unroll") for (int k = 0; k < 2; ++k) dst[m][k] = *(const LAS bf16x8*)(lds + PG8_SA(b, h) + aoff + m * 2048 + k * 1024); } while (0)
#define PG8_LDB(dst, b, h) do { _Pragma("unroll") for (int n = 0; n < 2; ++n) _Pragma("unroll") for (int k = 0; k < 2; ++k) dst[n][k] = *(const LAS bf16x8*)(lds + PG8_SB(b, h) + boff + n * 2048 + k * 1024); } while (0)
#define PG8_MMA(ai, bj, At, Bt) do { __builtin_amdgcn_s_setprio(1); _Pragma("unroll") for (int m = 0; m < 4; ++m) _Pragma("unroll") for (int n = 0; n < 2; ++n) _Pragma("unroll") for (int k = 0; k < 2; ++k) \
        acc[ai][bj][m][n] = __builtin_amdgcn_mfma_f32_16x16x32_bf16(Bt[n][k], At[m][k], acc[ai][bj][m][n], 0, 0, 0); __builtin_amdgcn_s_setprio(0); } while (0)
#define PG8_WAIT_V(n) asm volatile("s_waitcnt vmcnt(" #n ")" ::: "memory")
#define PG8_WAIT_L(n) asm volatile("s_waitcnt lgkmcnt(" #n ")" ::: "memory")
#define PG8_BAR __builtin_amdgcn_s_barrier()
#define PG8_SCHED __builtin_amdgcn_sched_barrier(0)
#define PG8_ROWOFS(dst, u) do { _Pragma("unroll") for (int _h = 0; _h < 2; ++_h) _Pragma("unroll") for (int _i = 0; _i < 2; ++_i) { \
        const int _r = (u).pm * BM + _h * HALF + sR[_i]; const unsigned _row = GATHER ? (unsigned)g.rowidx[_r] : (unsigned)_r; \
        dst[_h][_i] = (_row * (unsigned)K + (unsigned)sC[_i]) * 2u; } } while (0)
#define PG8_ROWRAW(dst, u) do { _Pragma("unroll") for (int _h = 0; _h < 2; ++_h) _Pragma("unroll") for (int _i = 0; _i < 2; ++_i) \
        dst[_h][_i] = (unsigned)g.rowidx[(u).pm * BM + _h * HALF + sR[_i]]; } while (0)
#define PG8_RAW2OFS(dst, raw) do { _Pragma("unroll") for (int _h = 0; _h < 2; ++_h) _Pragma("unroll") for (int _i = 0; _i < 2; ++_i) \
        dst[_h][_i] = (raw[_h][_i] * (unsigned)K + (unsigned)sC[_i]) * 2u; } while (0)
    Unit cur, nxt; int ui = 0;
    if (!S.next(0, cur)) return;
    f32x4 acc[2][2][4][2];
    f32x4 nb[2][2];
#pragma unroll
    for (int b = 0; b < 2; ++b)
#pragma unroll
        for (int n = 0; n < 2; ++n) nb[b][n] = (f32x4){0.f, 0.f, 0.f, 0.f};
    if constexpr (Epi::HAS_BIAS) E.load_bias(nb, cur, wc, fq);
#pragma unroll
    for (int a = 0; a < 2; ++a)
#pragma unroll
        for (int b = 0; b < 2; ++b)
#pragma unroll
            for (int m = 0; m < 4; ++m)
#pragma unroll
                for (int n = 0; n < 2; ++n) acc[a][b][m][n] = nb[b][n];
    bf16x8 At[4][2], B0[2][2], B1[2][2];
    unsigned cofs[2][2], nofs[2][2];
    PG8_ROWOFS(cofs, cur);
    bool has_next = S.next(1, nxt);
    unsigned nraw[2][2];
    if (GATHER && has_next) PG8_ROWRAW(nraw, nxt);
    const char* cAb = (const char*)((DUAL && (cur.pn >> 16)) ? g.A2 : g.A);
    const char* cB = (const char*)((DUAL && (cur.pn >> 16)) ? g.Bt2 : g.Bt) + (size_t)(cur.pn & 0xffff) * tstep;
    PG8_STAGE(PG8_SB(0, 0), cB, voffB); PG8_STAGE(PG8_SB(0, 1), cB + hstep, voffB); PG8_STAGEA(PG8_SA(0, 0), cAb, 0, cofs[0]); PG8_STAGEA(PG8_SA(0, 1), cAb, 0, cofs[1]);
    if (wr == 1) PG8_BAR;
    PG8_WAIT_V(2); PG8_BAR;
    PG8_STAGE(PG8_SB(1, 0), cB + kstep, voffB); PG8_STAGEA(PG8_SA(1, 0), cAb, kstep, cofs[0]); PG8_STAGE(PG8_SB(1, 1), cB + hstep + kstep, voffB);
    PG8_WAIT_V(6); PG8_BAR;
    for (;;) {
        if (has_next) { if (GATHER) { PG8_RAW2OFS(nofs, nraw); } else { PG8_ROWOFS(nofs, nxt); } }
        else {
#pragma unroll
            for (int h = 0; h < 2; ++h)
#pragma unroll
                for (int i = 0; i < 2; ++i) nofs[h][i] = cofs[h][i];
        }
        Unit n2; const bool has_n2 = has_next && S.next(ui + 2, n2);
        const char* nB = has_next ? (const char*)((DUAL && (nxt.pn >> 16)) ? g.Bt2 : g.Bt) + (size_t)(nxt.pn & 0xffff) * tstep : cB;
        const char* nAb = has_next ? (const char*)((DUAL && (nxt.pn >> 16)) ? g.A2 : g.A) : cAb;
        for (int t = 0; t < nt; t += 2) {
            const bool last = (t == nt - 2);
            const size_t k1 = (size_t)(t + 1) * kstep;
            const size_t k2 = last ? 0 : (size_t)(t + 2) * kstep; const size_t k3 = k2 + kstep;
            const char* b2 = last ? nB : cB + (size_t)(t + 2) * kstep; const char* b3 = b2 + kstep;
            const char* ab2 = last ? nAb : cAb;
            unsigned o2[2][2];
#pragma unroll
            for (int h = 0; h < 2; ++h)
#pragma unroll
                for (int i = 0; i < 2; ++i) o2[h][i] = last ? nofs[h][i] : cofs[h][i];
            PG8_LDB(B0, 0, 0); PG8_LDB(B1, 0, 1); PG8_SCHED; PG8_LDA(At, 0, 0); PG8_STAGEA(PG8_SA(1, 1), cAb, k1, cofs[1]);
            PG8_WAIT_V(8); PG8_WAIT_L(0); PG8_BAR; PG8_MMA(0, 0, At, B0); PG8_MMA(0, 1, At, B1); PG8_BAR; PG8_SCHED;
            PG8_LDA(At, 0, 1); PG8_STAGE(PG8_SB(0, 0), b2, voffB); PG8_STAGE(PG8_SB(0, 1), b2 + hstep, voffB); PG8_STAGEA(PG8_SA(0, 0), ab2, k2, o2[0]);
            PG8_WAIT_V(8); PG8_WAIT_L(0); PG8_BAR; PG8_MMA(1, 0, At, B0); PG8_MMA(1, 1, At, B1); PG8_BAR; PG8_SCHED;
            PG8_LDB(B0, 1, 0); PG8_LDB(B1, 1, 1); PG8_SCHED; PG8_LDA(At, 1, 0); PG8_STAGEA(PG8_SA(0, 1), ab2, k2, o2[1]);
            PG8_WAIT_V(8); PG8_WAIT_L(0); PG8_BAR; PG8_MMA(0, 0, At, B0); PG8_MMA(0, 1, At, B1); PG8_BAR; PG8_SCHED;
            PG8_LDA(At, 1, 1); PG8_STAGE(PG8_SB(1, 0), b3, voffB); PG8_STAGE(PG8_SB(1, 1), b3 + hstep, voffB); PG8_STAGEA(PG8_SA(1, 0), ab2, k3, o2[0]);
            PG8_WAIT_V(8); PG8_WAIT_L(0); PG8_BAR; PG8_MMA(1, 0, At, B0); PG8_MMA(1, 1, At, B1); PG8_BAR; PG8_SCHED;
        }
        if (wr == 0) PG8_BAR;
        if (GATHER && has_n2) { PG8_ROWRAW(nraw, n2); } if (GATHER) asm volatile("" ::: "memory");
        if constexpr (Epi::HAS_BIAS) { if (has_next) E.load_bias(nb, nxt, wc, fq); }
        E(acc, cur, wr, wc, fr, fq);
        if (!has_next) break;
        if (!DUAL || (cur.pn >> 16)) {
#pragma unroll
        for (int a = 0; a < 2; ++a)
#pragma unroll
            for (int b = 0; b < 2; ++b)
#pragma unroll
                for (int m = 0; m < 4; ++m)
#pragma unroll
                    for (int n = 0; n < 2; ++n) acc[a][b][m][n] = nb[b][n];
        }
        cur = nxt; cB = nB; cAb = nAb; ++ui; nxt = n2; has_next = has_n2;
#pragma unroll
        for (int h = 0; h < 2; ++h)
#pragma unroll
            for (int i = 0; i < 2; ++i) cofs[h][i] = nofs[h][i];
        if (wr == 1) PG8_BAR;
    }
    PG8_WAIT_V(0);
    PG8_BAR;
#undef PG8_SA
#undef PG8_SB
#undef PG8_STAGE
#undef PG8_STAGEA
#undef PG8_LDA
#undef PG8_LDB
#undef PG8_MMA
#undef PG8_WAIT_V
#undef PG8_WAIT_L
#undef PG8_BAR
#undef PG8_SCHED
#undef PG8_ROWOFS
#undef PG8_ROWRAW
#undef PG8_RAW2OFS
}
}
using pg8::Unit;
typedef f32x4 AccT[2][2][4][2];

struct Args { const float* in[25]; float* out; unsigned char* ws; int ph_lo, ph_hi; };
struct Frame { LAS unsigned char* lds; LAS unsigned char* misc; int tid, lane, wave, G, bid; };

#define IN_X 0
#define IN_C 1
#define IN_CTX 2
#define IN_CCTX 3
#define IN_WADA 4
#define IN_BADA 5
#define IN_N1W 6
#define IN_WIN 7
#define IN_GATEB 8
#define IN_CONVW 9
#define IN_CONVB 10
#define IN_WPOOL 11
#define IN_PSCALE 12
#define IN_HNW 13
#define IN_WBP 14
#define IN_WBM 15
#define IN_WOUT 16
#define IN_N2W 17
#define IN_WR 18
#define IN_BR 19
#define IN_W1 20
#define IN_B1 21
#define IN_W2 22
#define IN_B2 23
#define IN_FNW 24

__device__ __forceinline__ bf16* x1_row(float* out, unsigned char* ws, int t) { return t < XSPLIT ? (bf16*)out + (size_t)T * D + (size_t)t * D : (bf16*)(ws + WS_X1B) + (size_t)(t - XSPLIT) * D; }
template <class RowMap>
__device__ __forceinline__ void tr_item(const float* W, int K, int N, bf16* WT, LAS float* scr, int item, int lane, const RowMap& rowmap) {
    const int nblk = (N + 31) / 32, kb = item / nblk, nb = item % nblk, k0 = 64 * kb, n0 = 32 * nb;
    const int nn = n0 + (lane & 31);
#pragma unroll
    for (int i = 0; i < 32; ++i) { const int kk = 2 * i + (lane >> 5); scr[kk * 33 + (lane & 31)] = (nn < N) ? W[(size_t)(k0 + kk) * N + nn] : 0.f; }
    LDS_WAIT(); asm volatile("" ::: "memory");
    const int c = lane & 7;
#pragma unroll
    for (int j = 0; j < 4; ++j) { const int n = (lane >> 3) + 8 * j; const LAS float* s = scr + (8 * c) * 33 + n;
        u32x4 o; o.x = pk2(s[0 * 33], s[1 * 33]); o.y = pk2(s[2 * 33], s[3 * 33]); o.z = pk2(s[4 * 33], s[5 * 33]); o.w = pk2(s[6 * 33], s[7 * 33]);
        if (n0 + n < N) *(u32x4*)(WT + (size_t)rowmap(n0 + n) * K + k0 + 8 * c) = o; }
    LDS_WAIT(); asm volatile("" ::: "memory");
}
struct MapId { int off; __device__ __forceinline__ int operator()(int n) const { return off + n; } };
struct MapWin { __device__ __forceinline__ int operator()(int c) const { return c < 2560 ? c : (c < 2576 ? 4608 + (c - 2560) : c - 16); } };
struct MapW1 { int off; __device__ __forceinline__ int operator()(int n) const { const int up = n >= 1024, nn = n & 1023; return off + (nn >> 7) * 256 + up * 128 + (nn & 127); } };

__device__ __forceinline__ void p0_prologue(const Args& a, const Frame& F) {
    LAS float* scr = (LAS float*)(F.lds + F.wave * 8448);
    LAS float* sc = (LAS float*)(F.lds + 69632);
    LAS float* red = (LAS float*)(F.lds + 106496);
    unsigned char* ws = a.ws;
    for (int item = F.bid; item < 96; item += F.G) {
        __syncthreads();
        for (int i = F.tid; i < 9 * 1024; i += 512) { const int r = i >> 10, k = i & 1023; const float v = (r < 8) ? a.in[IN_C][r * 1024 + k] : a.in[IN_CCTX][k]; sc[i] = v * sigmoidf_(v); }
        __syncthreads();
        const int col = 64 * item + F.lane, k0 = F.wave * 128; const float* W = a.in[IN_WADA] + col;
        float acc[9];
#pragma unroll
        for (int q = 0; q < 9; ++q) acc[q] = 0.f;
        for (int kk = 0; kk < 128; kk += 8) {
            float wv[8];
#pragma unroll
            for (int u = 0; u < 8; ++u) wv[u] = W[(size_t)(k0 + kk + u) * 6144];
#pragma unroll
            for (int q = 0; q < 9; ++q) { const f32x4 s0 = *(const LAS f32x4*)(sc + q * 1024 + k0 + kk), s1 = *(const LAS f32x4*)(sc + q * 1024 + k0 + kk + 4);
                acc[q] += (s0.x * wv[0] + s0.y * wv[1]) + (s0.z * wv[2] + s0.w * wv[3]) + (s1.x * wv[4] + s1.y * wv[5]) + (s1.z * wv[6] + s1.w * wv[7]); }
        }
#pragma unroll
        for (int q = 0; q < 9; ++q) red[(F.wave * 9 + q) * 64 + F.lane] = acc[q];
        __syncthreads();
        for (int i = F.tid; i < 9 * 64; i += 512) { const int q = i >> 6, l = i & 63; float s = 0.f;
#pragma unroll
            for (int w8 = 0; w8 < 8; ++w8) s += red[(w8 * 9 + q) * 64 + l];
            ((float*)(ws + WS_MOD))[q * 6144 + 64 * item + l] = s + a.in[IN_BADA][64 * item + l]; }
    }
    __syncthreads();
    constexpr int I_WPA = 1024, I_WRT = 32, I_WGT = 16, I_WIN = 16 * 145, I_WBM = 8 * 32, I_WOUT = 16 * 32;
    constexpr int NITEMS = I_WPA + I_WRT + I_WGT + I_WIN + I_WBM + I_WOUT;
    const int nmodb = F.G < 96 ? F.G : 96, nwn = (F.G - nmodb) * 8, nfirst = 3 * nwn < NITEMS ? 3 * nwn : NITEMS;
    const bool modb = F.bid < nmodb;
    const int it0 = modb ? nfirst + F.bid * 8 + F.wave : (F.bid - nmodb) * 8 + F.wave, itend = modb ? NITEMS : nfirst, itstep = modb ? nmodb * 8 : nwn;
    for (int it = it0; it < itend; it += itstep) {
        int r = it;
        if (r < I_WPA) {
            const int g = r >> 8, cb = (r >> 4) & 15, n = (r & 15) * 64 + F.lane, k0 = g * 128 + cb * 8;
            const float* wp = a.in[IN_WPOOL] + (size_t)k0 * 128; const float* ps = a.in[IN_PSCALE] + g * 128; const float* wb = a.in[IN_WBP] + (size_t)(g * 128) * 1024 + n;
            float acc[8];
#pragma unroll
            for (int cc = 0; cc < 8; ++cc) acc[cc] = 0.f;
#pragma unroll 4
            for (int d = 0; d < 128; ++d) { const float wbv = wb[(size_t)d * 1024] * ps[d];
#pragma unroll
                for (int cc = 0; cc < 8; ++cc) acc[cc] += wp[cc * 128 + d] * wbv; }
            u32x4 o; o.x = pk2(acc[0], acc[1]); o.y = pk2(acc[2], acc[3]); o.z = pk2(acc[4], acc[5]); o.w = pk2(acc[6], acc[7]);
            *(u32x4*)((bf16*)(ws + WS_WPA_T) + (size_t)n * 512 + k0) = o;
            continue;
        }
        r -= I_WPA;
        if (r < I_WRT + I_WGT) {
            const bool isr = r < I_WRT; const int e = isr ? r : r - I_WRT; bf16* dst = (bf16*)(ws + (isr ? WS_WR_T : WS_WG_T)); const int nrow = isr ? 32 : 16;
#pragma unroll 4
            for (int i = 0; i < 16; ++i) { const int k = F.lane + 64 * i; const float v = isr ? a.in[IN_WR][k * 32 + e] : a.in[IN_WIN][(size_t)k * INW + 2560 + e];
                const unsigned hi = f2bf(v); const float rem = v - __uint_as_float(hi << 16);
                dst[e * 1024 + k] = (bf16)hi; dst[(nrow + e) * 1024 + k] = (bf16)f2bf(rem); }
            continue;
        }
        r -= I_WRT + I_WGT;
        if (r < I_WIN) { tr_item(a.in[IN_WIN], 1024, INW, (bf16*)(ws + WS_WIN_T), scr, r, F.lane, MapWin{}); continue; } r -= I_WIN;
        if (r < I_WBM) { tr_item(a.in[IN_WBM], 512, 1024, (bf16*)(ws + WS_WBM_T), scr, r, F.lane, MapId{0}); continue; } r -= I_WBM;
        tr_item(a.in[IN_WOUT], 1024, 1024, (bf16*)(ws + WS_WOUT_T), scr, r, F.lane, MapId{0});
    }
}

__device__ __forceinline__ u32x4 lane_perm(const u32x4 w, int baddr) {
    u32x4 r; r.x = (unsigned)__builtin_amdgcn_ds_bpermute(baddr, (int)w.x); r.y = (unsigned)__builtin_amdgcn_ds_bpermute(baddr, (int)w.y);
    r.z = (unsigned)__builtin_amdgcn_ds_bpermute(baddr, (int)w.z); r.w = (unsigned)__builtin_amdgcn_ds_bpermute(baddr, (int)w.w); return r; }
#define LANE_PERM_IDX() const int ln_ = fr + 16 * fq, pf = (ln_ >> 2) & 15, pq = ln_ & 3, baddr = 4 * (pf + 16 * pq)
template <int NT, bool XBF16>
__device__ __forceinline__ void norm_pair(const void* xrow, const LAS float* nwsL, const LAS float* shL, bf16* orow, const LAS unsigned char* Whi, const LAS unsigned char* Wlo,
                                          LAS float* red, int wave, int c, int q, f32x4 (&acc)[NT]) {
    const int hf = wave & 1;
    f32x4 xa[16], xb[16];
    if (XBF16) {
        const int lnx = c + 16 * q, iaddr = 4 * (4 * c + q);
        const u32x4* xp = (const u32x4*)xrow + 64 * hf + (lnx & 3);
        u32x4 xr[16];
#pragma unroll
        for (int j = 0; j < 16; ++j) xr[j] = xp[j * 4];
#pragma unroll
        for (int j = 0; j < 16; ++j) xr[j] = lane_perm(xr[j], iaddr);
#pragma unroll
        for (int j = 0; j < 16; ++j) { xa[j] = (f32x4){bflo(xr[j].x), bfhi(xr[j].x), bflo(xr[j].y), bfhi(xr[j].y)}; xb[j] = (f32x4){bflo(xr[j].z), bfhi(xr[j].z), bflo(xr[j].w), bfhi(xr[j].w)}; }
    } else {
        const int lnx = c + 16 * q, iaddr = 4 * (4 * c + q);
        const f32x4* xp = (const f32x4*)xrow + 128 * hf + 2 * (lnx & 3);
#pragma unroll
        for (int j = 0; j < 16; ++j) { xa[j] = xp[j * 8]; xb[j] = xp[j * 8 + 1]; }
#pragma unroll
        for (int j = 0; j < 16; ++j) { xa[j] = __builtin_bit_cast(f32x4, lane_perm(__builtin_bit_cast(u32x4, xa[j]), iaddr)); xb[j] = __builtin_bit_cast(f32x4, lane_perm(__builtin_bit_cast(u32x4, xb[j]), iaddr)); }
    }
    float ss = 0.f;
#pragma unroll
    for (int j = 0; j < 16; ++j) ss += ((xa[j].x * xa[j].x + xa[j].y * xa[j].y) + (xa[j].z * xa[j].z + xa[j].w * xa[j].w)) + ((xb[j].x * xb[j].x + xb[j].y * xb[j].y) + (xb[j].z * xb[j].z + xb[j].w * xb[j].w));
    ss += __shfl_xor(ss, 16); ss += __shfl_xor(ss, 32);
    if (q == 0) red[wave * 16 + c] = ss;
    LDS_BARRIER();
    const float rstd = rsqrtf((red[wave * 16 + c] + red[(wave ^ 1) * 16 + c]) * (1.f / 1024.f) + EPS);
    const LAS f32x4* np = (const LAS f32x4*)nwsL + 128 * hf + 2 * q; const LAS f32x4* hp = (const LAS f32x4*)shL + 128 * hf + 2 * q;
    const int ln_ = c + 16 * q, pq_ = ln_ & 3, baddr_ = 4 * (((ln_ >> 2) & 15) + 16 * pq_);
    u32x4* op = (u32x4*)orow + 64 * hf + pq_;
#pragma unroll
    for (int j = 0; j < 16; ++j) {
        const f32x4 y0 = (xa[j] * rstd) * np[j * 8] + hp[j * 8], y1 = (xb[j] * rstd) * np[j * 8 + 1] + hp[j * 8 + 1];
        u32x4 hi; hi.x = pg8::cvt_pk_bf16(y0.x, y0.y); hi.y = pg8::cvt_pk_bf16(y0.z, y0.w); hi.z = pg8::cvt_pk_bf16(y1.x, y1.y); hi.w = pg8::cvt_pk_bf16(y1.z, y1.w);
        op[j * 4] = lane_perm(hi, baddr_);
        u32x4 lo; lo.x = pg8::cvt_pk_bf16(y0.x - bflo(hi.x), y0.y - bfhi(hi.x)); lo.y = pg8::cvt_pk_bf16(y0.z - bflo(hi.y), y0.w - bfhi(hi.y));
        lo.z = pg8::cvt_pk_bf16(y1.x - bflo(hi.z), y1.y - bfhi(hi.z)); lo.w = pg8::cvt_pk_bf16(y1.z - bflo(hi.w), y1.w - bfhi(hi.w));
        const bf16x8 ah = __builtin_bit_cast(bf16x8, hi), al = __builtin_bit_cast(bf16x8, lo);
        const int wo = (((4 * (16 * hf + j) + q) ^ c) << 4);
#pragma unroll
        for (int nt = 0; nt < NT; ++nt) { const bf16x8 bh = *(const LAS bf16x8*)(Whi + (16 * nt + c) * 2048 + wo), bl = *(const LAS bf16x8*)(Wlo + (16 * nt + c) * 2048 + wo);
            acc[nt] = __builtin_amdgcn_mfma_f32_16x16x32_bf16(ah, bh, acc[nt], 0, 0, 0); acc[nt] = __builtin_amdgcn_mfma_f32_16x16x32_bf16(al, bh, acc[nt], 0, 0, 0); acc[nt] = __builtin_amdgcn_mfma_f32_16x16x32_bf16(ah, bl, acc[nt], 0, 0, 0); }
    }
}
__device__ __forceinline__ void p1_xn(const Args& a, const Frame& F) {
    LAS unsigned char* Whi = F.lds; LAS unsigned char* Wlo = F.lds + 32768;
    LAS float* NWS = (LAS float*)(F.lds + 65536); LAS float* SHV = (LAS float*)(F.lds + 65536 + 8192);
    LAS float* red = (LAS float*)(F.lds + 81920);
    LAS f32x4* accb = (LAS f32x4*)(F.lds + 82432);
    const bf16* wg = (const bf16*)(a.ws + WS_WG_T);
    const float* mod = (const float*)(a.ws + WS_MOD);
    const int c = F.lane & 15, q = F.lane >> 4, pair = F.wave >> 1;
    bf16* XN = (bf16*)(a.ws + WS_XN); float* GT = (float*)(a.ws + WS_GATES);
    for (int blk = F.bid; blk < 256; blk += F.G) {
        const int mrb = blk >> 5;
        __syncthreads();
        for (int i = F.tid; i < 2 * 16 * 128; i += 512) { const int part = i >> 11, r = (i >> 7) & 15, c16 = i & 127;
            *(LAS u32x4*)((part ? Wlo : Whi) + r * 2048 + ((c16 ^ r) << 4)) = *(const u32x4*)(wg + (size_t)part * 16384 + r * 1024 + c16 * 8); }
        for (int i = F.tid; i < 2 * 1024; i += 512) { const int mr = (i >> 10) ? 8 : mrb, k = i & 1023; NWS[i] = a.in[IN_N1W][k] * (1.0f + mod[mr * 6144 + 1024 + k]); SHV[i] = mod[mr * 6144 + k]; }
        __syncthreads();
        const int nstep = (blk < 32) ? 5 : 4;
        for (int st = 0; st < nstep; ++st) {
            const bool isctx = st == 4;
            const int tile = isctx ? (T / 16 + blk * 4 + pair) : (blk * 16 + st * 4 + pair);
            const int r = tile * 16 + ((F.lane >> 2) & 15);
            const float* src = isctx ? a.in[IN_CTX] + (size_t)(r - T) * D : a.in[IN_X] + (size_t)r * D;
            f32x4 acc[1]; acc[0] = (f32x4){0.f, 0.f, 0.f, 0.f};
            norm_pair<1, false>(src, NWS + (isctx ? 1024 : 0), SHV + (isctx ? 1024 : 0), XN + (size_t)(tile * 16 + ((F.lane >> 2) & 15)) * D, Whi, Wlo, red, F.wave, c, q, acc);
            if (F.wave & 1) accb[pair * 64 + F.lane] = acc[0];
            LDS_BARRIER();
            if (!(F.wave & 1)) { const f32x4 o = acc[0] + accb[pair * 64 + F.lane];
#pragma unroll
                for (int j = 0; j < 4; ++j) GT[(size_t)(tile * 16 + 4 * q + j) * 16 + c] = o[j]; }
        }
    }
}

struct SchedIn { int G, c;
    __device__ __forceinline__ bool next(int i, Unit& u) const {
        long L = (long)i * G + c;
        if (L < 256 * 18) { pg8::static_unit((int)L, 256, 18, u); return true; }
        L -= 256 * 18; if (L >= 48) return false;
        u.pm = 256 + (int)(L / 6); u.pn = 2 + (int)(L % 6); return true; } };
__device__ __forceinline__ unsigned pk4_fp8(float a, float b, float c, float d) { int p = __builtin_amdgcn_cvt_pk_fp8_f32(a, b, 0, false); p = __builtin_amdgcn_cvt_pk_fp8_f32(c, d, p, true); return (unsigned)p; }
__device__ __forceinline__ void un4_fp8(unsigned w, float (&o)[4]) { const auto lo = __builtin_amdgcn_cvt_pk_f32_fp8((int)w, false), hi = __builtin_amdgcn_cvt_pk_f32_fp8((int)w, true); o[0] = lo[0]; o[1] = lo[1]; o[2] = hi[0]; o[3] = hi[1]; }
__device__ __forceinline__ size_t pmerge8_off(int pm, int k, int wid, int am, int lane) { return ((((size_t)(pm * 8 + k) * 8 + wid) * 8 + am) * 64 + lane) * 16; }
struct EpiIn { static constexpr bool PERM = true, HAS_BIAS = false;
    bf16 *ppool, *pqk, *pv, *po; unsigned char* pmerge;
    __device__ __forceinline__ void operator()(AccT& acc, const Unit& u, int wr, int wc, int fr, int fq) const {
        const int pn = u.pn;
        if (pn >= 10) {
#pragma unroll
            for (int ai = 0; ai < 2; ++ai)
#pragma unroll
                for (int m = 0; m < 4; ++m) { u32x4 w;
#pragma unroll
                    for (int bj = 0; bj < 2; ++bj) { f32x4 v0 = acc[ai][bj][m][0], v1 = acc[ai][bj][m][1];
                        v0 *= -1.4426950408889634f; v1 *= -1.4426950408889634f;
                        const unsigned lo = pk4_fp8(v0[0], v0[1], v0[2], v0[3]), hi = pk4_fp8(v1[0], v1[1], v1[2], v1[3]);
                        if (bj == 0) { w.x = lo; w.y = hi; } else { w.z = lo; w.w = hi; } }
                    *(u32x4*)(pmerge + pmerge8_off(u.pm, pn - 10, wr * 4 + wc, ai * 4 + m, fr + 16 * fq)) = w; }
            return;
        }
        LANE_PERM_IDX();
        const int row0 = u.pm * 256 + wr * 64 + pf;
        {
            bf16* base; int ld, colt;
            if (pn < 2) { base = ppool; ld = 512; colt = 256 * pn; } else if (pn < 6) { base = pqk; ld = 1024; colt = 256 * (pn - 2); }
            else if (pn < 8) { base = pv; ld = 512; colt = 256 * (pn - 6); } else { base = po; ld = 512; colt = 256 * (pn - 8); }
            const int col0 = colt + wc * 32 + 8 * pq;
#pragma unroll
            for (int ai = 0; ai < 2; ++ai)
#pragma unroll
                for (int m = 0; m < 4; ++m) { bf16* rowp = base + (size_t)(row0 + ai * 128 + m * 16) * ld + col0;
#pragma unroll
                    for (int bj = 0; bj < 2; ++bj) { const f32x4 v0 = acc[ai][bj][m][0], v1 = acc[ai][bj][m][1];
                        u32x4 w; w.x = pg8::cvt_pk_bf16(v0[0], v0[1]); w.y = pg8::cvt_pk_bf16(v0[2], v0[3]); w.z = pg8::cvt_pk_bf16(v1[0], v1[1]); w.w = pg8::cvt_pk_bf16(v1[2], v1[3]);
                        *(u32x4*)(rowp + bj * 128) = lane_perm(w, baddr); } }
        }
    } };
struct SchedMerge { int G, c;
    __device__ __forceinline__ bool next(int i, Unit& u) const { const long L = (long)(i >> 1) * G + c; if (L >= 1024) return false; pg8::static_unit((int)L, 256, 4, u); u.pn |= (i & 1) << 16; return true; } };
struct EpiMerge { static constexpr bool PERM = true, HAS_BIAS = false;
    const unsigned char* pmerge; bf16* Y;
    template <bool HI> static __device__ __forceinline__ f32x2 e1p(unsigned w) { const auto x = __builtin_amdgcn_cvt_pk_f32_fp8((int)w, HI); f32x2 e; e.x = __builtin_amdgcn_exp2f(x[0]); e.y = __builtin_amdgcn_exp2f(x[1]); return e + 1.0f; }
    static __device__ __forceinline__ f32x2 rcp2(f32x2 d) { f32x2 r; r.x = frcp_(d.x); r.y = frcp_(d.y); return r; }
    __device__ __forceinline__ void operator()(AccT& acc, const Unit& u, int wr, int wc, int fr, int fq) const {
        const int sel = u.pn >> 16, pn = u.pn & 0xffff, wid = wr * 4 + wc, ln = fr + 16 * fq;
        if (sel == 0) {
            u32x4 ga[8], gb[8];
#pragma unroll
            for (int am = 0; am < 8; ++am) { ga[am] = *(const u32x4*)(pmerge + pmerge8_off(u.pm, pn, wid, am, ln)); gb[am] = *(const u32x4*)(pmerge + pmerge8_off(u.pm, 4 + pn, wid, am, ln)); }
#pragma unroll
            for (int am = 0; am < 8; ++am) { const int ai = am >> 2, m = am & 3;
#pragma unroll
                for (int bj = 0; bj < 2; ++bj)
#pragma unroll
                    for (int n = 0; n < 2; ++n) { const unsigned wa = bj ? (n ? ga[am].w : ga[am].z) : (n ? ga[am].y : ga[am].x), wb = bj ? (n ? gb[am].w : gb[am].z) : (n ? gb[am].y : gb[am].x);
                        f32x4& v = acc[ai][bj][m][n];
                        const f32x2 r0 = e1p<false>(wb) * rcp2(e1p<false>(wa)), r1 = e1p<true>(wb) * rcp2(e1p<true>(wa));
                        v[0] *= r0.x; v[1] *= r0.y; v[2] *= r1.x; v[3] *= r1.y; } }
        } else {
            LANE_PERM_IDX();
            const int rowP = u.pm * 256 + wr * 64 + pf, colP = pn * 256 + wc * 32 + 8 * pq;
            u32x4 gb[8];
#pragma unroll
            for (int am = 0; am < 8; ++am) gb[am] = *(const u32x4*)(pmerge + pmerge8_off(u.pm, 4 + pn, wid, am, ln));
#pragma unroll
            for (int am = 0; am < 8; ++am) { const int ai = am >> 2, m = am & 3;
#pragma unroll
                for (int bj = 0; bj < 2; ++bj) { const f32x4 v0 = acc[ai][bj][m][0], v1 = acc[ai][bj][m][1];
                    const unsigned w0 = bj ? gb[am].z : gb[am].x, w1 = bj ? gb[am].w : gb[am].y;
                    const f32x2 s00 = rcp2(e1p<false>(w0)), s01 = rcp2(e1p<true>(w0)), s10 = rcp2(e1p<false>(w1)), s11 = rcp2(e1p<true>(w1));
                    const f32x2 y00 = s00 * (f32x2){v0[0], v0[1]}, y01 = s01 * (f32x2){v0[2], v0[3]}, y10 = s10 * (f32x2){v1[0], v1[1]}, y11 = s11 * (f32x2){v1[2], v1[3]};
                    u32x4 w; w.x = pg8::cvt_pk_bf16(y00.x, y00.y); w.y = pg8::cvt_pk_bf16(y01.x, y01.y); w.z = pg8::cvt_pk_bf16(y10.x, y10.y); w.w = pg8::cvt_pk_bf16(y11.x, y11.y);
                    *(u32x4*)(Y + (size_t)(rowP + ai * 128 + m * 16) * 1024 + colP + bj * 128) = lane_perm(w, baddr); } }
        }
    } };
struct EpiOut { static constexpr bool PERM = true, HAS_BIAS = false;
    const float* x; const float* mod; float* out; unsigned char* ws;
    __device__ __forceinline__ void operator()(AccT& acc, const Unit& u, int wr, int wc, int fr, int fq) const {
        LANE_PERM_IDX();
        const int col0 = u.pn * 256 + wc * 32 + 8 * fq, rowP = u.pm * 256 + wr * 64 + pf, colP = u.pn * 256 + wc * 32 + 8 * pq;
        const float* g1 = mod + (u.pm >> 5) * 6144 + 2048 + col0;
        f32x4 gv[2][2];
#pragma unroll
        for (int bj = 0; bj < 2; ++bj)
#pragma unroll
            for (int n = 0; n < 2; ++n) gv[bj][n] = *(const f32x4*)(g1 + bj * 128 + n * 4);
        bf16* x1b = x1_row(out, ws, u.pm * 256);
#pragma unroll
        for (int am = 0; am < 4; ++am) { const int ai = am >> 1, m0 = (am & 1) * 2;
            f32x4 xv[2][2][2];
#pragma unroll
            for (int mm = 0; mm < 2; ++mm)
#pragma unroll
                for (int bj = 0; bj < 2; ++bj)
#pragma unroll
                    for (int n = 0; n < 2; ++n) xv[mm][bj][n] = *(const f32x4*)(x + (size_t)(rowP + ai * 128 + (m0 + mm) * 16) * 1024 + colP + bj * 128 + n * 4);
#pragma unroll
            for (int mm = 0; mm < 2; ++mm)
#pragma unroll
                for (int bj = 0; bj < 2; ++bj) { const int m = m0 + mm; const f32x4 t0 = gv[bj][0] * acc[ai][bj][m][0], t1 = gv[bj][1] * acc[ai][bj][m][1];
                    u32x4 d; d.x = pg8::cvt_pk_bf16(t0[0], t0[1]); d.y = pg8::cvt_pk_bf16(t0[2], t0[3]); d.z = pg8::cvt_pk_bf16(t1[0], t1[1]); d.w = pg8::cvt_pk_bf16(t1[2], t1[3]);
                    d = lane_perm(d, baddr);
                    const f32x4 x0 = xv[mm][bj][0], x1 = xv[mm][bj][1];
                    u32x4 w; w.x = pg8::cvt_pk_bf16(x0[0] + bflo(d.x), x0[1] + bfhi(d.x)); w.y = pg8::cvt_pk_bf16(x0[2] + bflo(d.y), x0[3] + bfhi(d.y));
                    w.z = pg8::cvt_pk_bf16(x1[0] + bflo(d.z), x1[1] + bfhi(d.z)); w.w = pg8::cvt_pk_bf16(x1[2] + bflo(d.w), x1[3] + bfhi(d.w));
                    *(u32x4*)(x1b + (size_t)(wr * 64 + pf + ai * 128 + m * 16) * 1024 + colP + bj * 128) = w; }
            asm volatile("" ::: "memory");
        }
    } };
struct SchedMoe { int G, c, NT, tlo, thi; const LAS unsigned char* tile_g;
    __device__ __forceinline__ bool next(int i, Unit& u) const {
        int tile, pnl;
        if (G == 256) { const int x = c & 7, j = c >> 3, tpx = 32 / NT; tile = tlo + i * (8 * tpx) + x * tpx + j / NT; pnl = j % NT; }
        else { const long L = (long)i * G + c; tile = tlo + (int)(L / NT); pnl = (int)(L % NT); }
        if (tile >= thi) return false;
        const int e = tile_g[tile] & 31; u.pm = tile; u.pn = e * NT + pnl; return true; } };
struct EpiMoe1 { static constexpr bool PERM = true, HAS_BIAS = true;
    const float* b1; bf16* act;
    __device__ __forceinline__ void load_bias(f32x4 (&nb)[2][2], const Unit& u, int wc, int fq) const {
        const int e = u.pn >> 3, pnl = u.pn & 7; const float* bg = b1 + (size_t)e * 2048 + pnl * 128 + wc * 32 + 8 * fq;
        nb[0][0] = *(const f32x4*)bg; nb[0][1] = *(const f32x4*)(bg + 4); nb[1][0] = *(const f32x4*)(bg + 1024); nb[1][1] = *(const f32x4*)(bg + 1028); }
    __device__ __forceinline__ void operator()(AccT& acc, const Unit& u, int wr, int wc, int fr, int fq) const {
        LANE_PERM_IDX();
        const int pnl = u.pn & 7, row0 = u.pm * 256 + wr * 64 + pf, jc = pnl * 128 + wc * 32 + 8 * pq;
#pragma unroll
        for (int ai = 0; ai < 2; ++ai)
#pragma unroll
            for (int m = 0; m < 4; ++m) {
                const f32x4 g0 = acc[ai][0][m][0], g1 = acc[ai][0][m][1], u0 = acc[ai][1][m][0], u1 = acc[ai][1][m][1];
                float r[8];
#pragma unroll
                for (int h2 = 0; h2 < 4; ++h2) { const f32x4& gs = (h2 < 2) ? g0 : g1; const f32x4& us = (h2 < 2) ? u0 : u1; const int j0 = (h2 & 1) * 2;
                    f32x2 gv2 = (f32x2){__builtin_amdgcn_fmed3f(gs[j0], -3.0e38f, 7.0f), __builtin_amdgcn_fmed3f(gs[j0 + 1], -3.0e38f, 7.0f)};
                    f32x2 uv2 = (f32x2){__builtin_amdgcn_fmed3f(us[j0], -7.0f, 7.0f), __builtin_amdgcn_fmed3f(us[j0 + 1], -7.0f, 7.0f)};
                    const f32x2 t2 = gv2 * -2.4554669595930157f;
                    f32x2 e2; e2.x = __builtin_amdgcn_exp2f(t2.x); e2.y = __builtin_amdgcn_exp2f(t2.y);
                    const f32x2 d2 = e2 + 1.0f;
                    f32x2 s2; s2.x = frcp_(d2.x); s2.y = frcp_(d2.y);
                    const f32x2 o2 = __builtin_elementwise_fma(uv2, gv2, gv2) * s2;
                    r[h2 * 2] = o2.x; r[h2 * 2 + 1] = o2.y; }
                u32x4 w; w.x = pg8::cvt_pk_bf16(r[0], r[1]); w.y = pg8::cvt_pk_bf16(r[2], r[3]); w.z = pg8::cvt_pk_bf16(r[4], r[5]); w.w = pg8::cvt_pk_bf16(r[6], r[7]);
                *(u32x4*)(act + (size_t)(row0 + ai * 128 + m * 16) * 1024 + jc) = lane_perm(w, baddr); }
    } };
struct EpiMoe2 { static constexpr bool PERM = true, HAS_BIAS = true;
    const float* b2; bf16* outk; int rowbase;
    __device__ __forceinline__ void load_bias(f32x4 (&nb)[2][2], const Unit& u, int wc, int fq) const {
        const int e = u.pn >> 2, pnl = u.pn & 3; const float* bp = b2 + (size_t)e * 1024 + pnl * 256 + wc * 32 + 8 * fq;
#pragma unroll
        for (int bj = 0; bj < 2; ++bj) { nb[bj][0] = *(const f32x4*)(bp + bj * 128); nb[bj][1] = *(const f32x4*)(bp + bj * 128 + 4); } }
    __device__ __forceinline__ void operator()(AccT& acc, const Unit& u, int wr, int wc, int fr, int fq) const {
        LANE_PERM_IDX();
        const int pnl = u.pn & 3, row0 = u.pm * 256 - rowbase + wr * 64 + pf, col0 = pnl * 256 + wc * 32 + 8 * pq;
#pragma unroll
        for (int ai = 0; ai < 2; ++ai)
#pragma unroll
            for (int m = 0; m < 4; ++m) { bf16* rowp = outk + (size_t)(row0 + ai * 128 + m * 16) * 1024 + col0;
#pragma unroll
                for (int bj = 0; bj < 2; ++bj) { const f32x4 v0 = acc[ai][bj][m][0], v1 = acc[ai][bj][m][1];
                    u32x4 o; o.x = pg8::cvt_pk_bf16(v0[0], v0[1]); o.y = pg8::cvt_pk_bf16(v0[2], v0[3]); o.z = pg8::cvt_pk_bf16(v1[0], v1[1]); o.w = pg8::cvt_pk_bf16(v1[2], v1[3]);
                    *(u32x4*)(rowp + bj * 128) = lane_perm(o, baddr); } }
    } };

__device__ __forceinline__ void gate_scans(const Args& a, const Frame& F, int b0, int nb) {
    {
        const float* GT = (const float*)(a.ws + WS_GATES); float* GS = (float*)(a.ws + WS_GS); float* CH = (float*)(a.ws + WS_CHK);
        const int gw = (F.bid - b0) * 8 + F.wave, NGW = nb * 8, lane = F.lane;
        for (int it = gw; it < (TA / 128) * 8; it += NGW) {
            const int chunk = it >> 3, hd = it & 7, dir = hd >> 2, h = hd & 3, c0r = chunk * 128, t0 = 2 * lane;
            const int r0 = c0r + (dir ? 127 - t0 : t0), r1 = c0r + (dir ? 126 - t0 : t0 + 1);
            const int gi = (dir ? 8 : 0) + h, gf = (dir ? 12 : 4) + h; const float gbi = a.in[IN_GATEB][gi], gbf = a.in[IN_GATEB][gf];
            const float i0 = GT[(size_t)r0 * 16 + gi] + gbi, i1 = GT[(size_t)r1 * 16 + gi] + gbi, f0 = GT[(size_t)r0 * 16 + gf] + gbf, f1 = GT[(size_t)r1 * 16 + gf] + gbf;
            const float l0 = fminf(f0, 0.f) - __logf(1.0f + __expf(-fabsf(f0))), l1 = fminf(f1, 0.f) - __logf(1.0f + __expf(-fabsf(f1)));
            const float p1 = l0 + l1; float inc = p1;
#pragma unroll
            for (int o = 1; o < 64; o <<= 1) { const float t = __shfl_up(inc, o); if (lane >= o) inc += t; }
            const float exc = inc - p1, b0 = exc + l0, b1 = inc;
            const float g0 = i0 - b0, g1 = i1 - b1; float im = fmaxf(g0, g1);
#pragma unroll
            for (int o = 1; o < 64; o <<= 1) { const float t = __shfl_up(im, o); if (lane >= o) im = fmaxf(im, t); }
            float em = __shfl_up(im, 1); if (lane == 0) em = -INFINITY;
            GS[(size_t)hd * TA + r0] = g0; GS[(size_t)hd * TA + r1] = g1;
            GS[(size_t)(8 + hd) * TA + r0] = fmaxf(em, g0); GS[(size_t)(8 + hd) * TA + r1] = im;
            GS[(size_t)(16 + hd) * TA + r0] = b0; GS[(size_t)(16 + hd) * TA + r1] = b1;
            if (lane == 63) { CH[(hd * 528 + chunk) * 2] = inc; CH[(hd * 528 + chunk) * 2 + 1] = im; }
        }
    }
}
__device__ __forceinline__ void p3_conv(const Args& a, const Frame& F) {
    const bf16* PQK = (const bf16*)(a.ws + WS_PQK); bf16* QKC = (bf16*)(a.ws + WS_QKC);
    const float* cw = a.in[IN_CONVW]; const float* cb = a.in[IN_CONVB];
    const int cg = F.tid & 127, sub = F.tid >> 7, c0 = cg * 8;
    float w0[8], w1[8], w2[8], bb[8];
#pragma unroll
    for (int j = 0; j < 8; ++j) { w0[j] = cw[c0 + j]; w1[j] = cw[1024 + c0 + j]; w2[j] = cw[2048 + c0 + j]; bb[j] = cb[c0 + j]; }
    const float scl = c0 < 512 ? 0.08838834764831845f : 1.0f;
    const u32x4 z = (u32x4){0u, 0u, 0u, 0u};
    for (int item = F.bid * 4 + sub; item < TA / 16; item += F.G * 4) {
        const int r0 = item * 16;
        const int len = (r0 < T) ? SEQ : CTXL, pos0 = (r0 < T) ? (r0 & (SEQ - 1)) : ((r0 - T) & (CTXL - 1));
        u32x4 rw[18];
#pragma unroll
        for (int i = 0; i < 18; ++i) { const int pos = pos0 + i - 1; rw[i] = (pos >= 0 && pos < len) ? *(const u32x4*)(PQK + (size_t)(r0 + i - 1) * 1024 + c0) : z; }
#pragma unroll
        for (int i = 0; i < 16; ++i) {
            const unsigned wm[4] = {rw[i].x, rw[i].y, rw[i].z, rw[i].w}, wc_[4] = {rw[i + 1].x, rw[i + 1].y, rw[i + 1].z, rw[i + 1].w}, wp[4] = {rw[i + 2].x, rw[i + 2].y, rw[i + 2].z, rw[i + 2].w};
            float o[8];
#pragma unroll
            for (int j = 0; j < 4; ++j) {
                const float a0 = bb[2 * j] + bflo(wm[j]) * w0[2 * j] + bflo(wc_[j]) * w1[2 * j] + bflo(wp[j]) * w2[2 * j];
                const float a1 = bb[2 * j + 1] + bfhi(wm[j]) * w0[2 * j + 1] + bfhi(wc_[j]) * w1[2 * j + 1] + bfhi(wp[j]) * w2[2 * j + 1];
                o[2 * j] = a0 * sigmoidf_(a0) * scl; o[2 * j + 1] = a1 * sigmoidf_(a1) * scl; }
            u32x4 w; w.x = pk2(o[0], o[1]); w.y = pk2(o[2], o[3]); w.z = pk2(o[4], o[5]); w.w = pk2(o[6], o[7]);
            *(u32x4*)(QKC + (size_t)(r0 + i) * 1024 + c0) = w;
        }
    }
}

constexpr int SP = 272;
constexpr int S_QS = 0, S_K0 = 34816, S_K1 = 69632, S_VT = 104448, S_VA0 = 113424, S_VA1 = 122400, S_CT = 131376, S_GL = 144432, S_PM = 144944, S_BL = 145456;
__device__ __forceinline__ unsigned off_b(unsigned row, unsigned ch) { return 256u * row + 16u * (ch ^ (((row & 3u) << 2) | ((row >> 2) & 3u))); }
__device__ __forceinline__ bf16x8 mk_frag(u32x2 lo, u32x2 hi) { u32x4 v; v.x = lo.x; v.y = lo.y; v.z = hi.x; v.w = hi.y; return __builtin_bit_cast(bf16x8, v); }
__device__ __forceinline__ void tr_read_k8(u32x2 (&r)[8], const unsigned (&ad)[8]) {
    asm volatile(
        "ds_read_b64_tr_b16 %0, %8\n\tds_read_b64_tr_b16 %1, %9\n\tds_read_b64_tr_b16 %2, %10\n\tds_read_b64_tr_b16 %3, %11\n\t"
        "ds_read_b64_tr_b16 %4, %12\n\tds_read_b64_tr_b16 %5, %13\n\tds_read_b64_tr_b16 %6, %14\n\tds_read_b64_tr_b16 %7, %15\n\t"
        "s_waitcnt lgkmcnt(0)"
        : "=&v"(r[0]), "=&v"(r[1]), "=&v"(r[2]), "=&v"(r[3]), "=&v"(r[4]), "=&v"(r[5]), "=&v"(r[6]), "=&v"(r[7])
        : "v"(ad[0]), "v"(ad[1]), "v"(ad[2]), "v"(ad[3]), "v"(ad[4]), "v"(ad[5]), "v"(ad[6]), "v"(ad[7]) : "memory");
}
__device__ __forceinline__ void p4_scan(const Args& a, const Frame& F) {
    LAS unsigned char* L = F.lds;
    const bf16* QKC = (const bf16*)(a.ws + WS_QKC); const bf16* PV = (const bf16*)(a.ws + WS_PV);
    const float* GS = (const float*)(a.ws + WS_GS); const float* CH = (const float*)(a.ws + WS_CHK);
    const int tid = F.tid, lane = F.lane, w = F.wave, c = lane & 15, q = lane >> 4;
    LAS float* GL = (LAS float*)(L + S_GL); LAS float* PML = (LAS float*)(L + S_PM); LAS float* BL = (LAS float*)(L + S_BL);
    const unsigned Lb = (unsigned)(size_t)L;
    for (int blk = F.bid; blk < 256; blk += F.G) {
        const int xx = blk & 7, yy = blk >> 3, sub = yy & 7, bh = xx * 4 + (yy >> 3);
        const int vs = sub & 3, dir = sub >> 2, h = bh & 3, b = bh >> 2, hd = dir * 4 + h;
        bf16* HX = (bf16*)(a.ws + (dir ? WS_HB : WS_HF));
        __syncthreads();
        for (int i = tid; i < 128; i += 512) *(LAS bf16*)(L + S_VT + 32 * SP + i * 2) = (bf16)0x3F80;
        for (int i = tid; i < 48 * 136; i += 512) *(LAS bf16*)(L + S_CT + i * 2) = (bf16)0;
        auto chunk_base = [&](int ci) -> int { if (ci < 2) { const int cx = dir ? (1 - ci) : ci; return T + b * CTXL + cx * 128; } const int cx = dir ? (63 - (ci - 2)) : (ci - 2); return b * SEQ + cx * 128; };
        if (w >= 4) {
            int ht = tid - 256; asm volatile("" : "+v"(ht));
            u32x4 pq[8], pk[8], pv[2]; float pga[2], pgl[2], pbt = 0.f, ppx = 0.f, mcar = 0.f;
            pgl[0] = 0.f; pgl[1] = 0.f;
            auto prefetch = [&](int ci) {
                const int base = chunk_base(ci);
#pragma unroll
                for (int i = 0; i < 8; ++i) { const int p = ht + 256 * i, row = p >> 4, c16 = p & 15; const int tok = base + (dir ? 127 - row : row);
                    pq[i] = *(const u32x4*)(QKC + (size_t)tok * 1024 + h * 128 + c16 * 8); pk[i] = *(const u32x4*)(QKC + (size_t)tok * 1024 + 512 + h * 128 + c16 * 8); }
#pragma unroll
                for (int i = 0; i < 2; ++i) { const int p = ht + 256 * i, row = p >> 2, cc = p & 3; const int tok = base + (dir ? 127 - row : row);
                    pv[i] = *(const u32x4*)(PV + (size_t)tok * 512 + h * 128 + vs * 32 + cc * 8); pga[i] = GS[(size_t)hd * TA + tok]; }
#pragma unroll
                for (int i = 0; i < 2; ++i) { const int idx = ht + 256 * i; if (idx < 384) { const int row = idx & 127, arr = idx >> 7; const int tok = base + (dir ? 127 - row : row); pgl[i] = GS[(size_t)(arr * 8 + hd) * TA + tok]; } }
                pbt = CH[(hd * 528 + (base >> 7)) * 2]; ppx = CH[(hd * 528 + (base >> 7)) * 2 + 1];
            };
            auto commitK = [&](int kbuf) {
#pragma unroll
                for (int i = 0; i < 8; ++i) { const int p = ht + 256 * i, row = p >> 4, c16 = p & 15; *(LAS u32x4*)(L + kbuf + row * SP + c16 * 16) = pk[i]; } };
            auto commitQ = [&]() {
#pragma unroll
                for (int i = 0; i < 8; ++i) { const int p = ht + 256 * i, row = p >> 4, c16 = p & 15; *(LAS u32x4*)(L + S_QS + row * SP + c16 * 16) = pq[i]; } };
            auto commitV = [&](float mprev, int vabuf) {
#pragma unroll
                for (int i = 0; i < 2; ++i) { const int p = ht + 256 * i, row = p >> 2, cc = p & 3; const unsigned wv[4] = {pv[i].x, pv[i].y, pv[i].z, pv[i].w};
                    const float av = __expf(pga[i] - fmaxf(ppx, mprev));
#pragma unroll
                    for (int j = 0; j < 4; ++j) { const unsigned sc2 = pg8::cvt_pk_bf16(av * bflo(wv[j]), av * bfhi(wv[j]));
                        *(LAS bf16*)(L + S_VT + (cc * 8 + 2 * j) * SP + row * 2) = (bf16)(wv[j] & 0xffffu); *(LAS bf16*)(L + S_VT + (cc * 8 + 2 * j + 1) * SP + row * 2) = (bf16)(wv[j] >> 16);
                        *(LAS bf16*)(L + vabuf + (cc * 8 + 2 * j) * SP + row * 2) = (bf16)(sc2 & 0xffffu); *(LAS bf16*)(L + vabuf + (cc * 8 + 2 * j + 1) * SP + row * 2) = (bf16)(sc2 >> 16); }
                    if (cc == 0) *(LAS bf16*)(L + vabuf + 32 * SP + row * 2) = (bf16)f2bf(av); }
#pragma unroll
                for (int i = 0; i < 2; ++i) { const int idx = ht + 256 * i; if (idx < 384) { const int row = idx & 127, arr = idx >> 7; *(LAS float*)(L + S_GL + arr * 512 + row * 4) = pgl[i]; } }
            };
            prefetch(0);
            LDS_BARRIER();
            commitK(S_K0); commitQ(); commitV(0.f, S_VA0);
            float btot = pbt, pmx = ppx;
            LDS_BARRIER();
            const int lw = blk * 4 + (w - 4);
            float cv[32]; bf16* cD = nullptr; int ck0 = 0, crow = 0;
            auto conv_load = [&](int it) {
                const float* cW; int cN, cn;
                if (it < 32768) { const int e = it >> 10, sb = it & 1023; ck0 = (sb >> 6) * 64; cn = (sb & 63) * 32 + (lane & 31); cN = 2048; cW = a.in[IN_W1] + (size_t)e * 1024 * 2048; cD = (bf16*)(a.ws + WS_W1T);
                    const int up = cn >= 1024, nn = cn & 1023; crow = e * 2048 + (nn >> 7) * 256 + up * 128 + (nn & 127); }
                else { const int it2 = it - 32768, e = it2 >> 9, sb = it2 & 511; ck0 = (sb >> 5) * 64; cn = (sb & 31) * 32 + (lane & 31); cN = 1024; cW = a.in[IN_W2] + (size_t)e * 1024 * 1024; cD = (bf16*)(a.ws + WS_W2T); crow = e * 1024 + cn; }
#pragma unroll
                for (int i = 0; i < 32; ++i) cv[i] = cW[(size_t)(ck0 + (lane >> 5) + 2 * i) * cN + cn];
            };
            auto conv_store = [&]() {
                const bool hi = lane >= 32;
                u32x4 o[4];
#pragma unroll
                for (int i = 0; i < 16; ++i) { const float snd = hi ? cv[i] : cv[16 + i]; const float rcv = __shfl_xor(snd, 32);
                    const unsigned pkd = pg8::cvt_pk_bf16(hi ? rcv : cv[i], hi ? cv[16 + i] : rcv);
                    if ((i & 3) == 0) o[i >> 2].x = pkd; else if ((i & 3) == 1) o[i >> 2].y = pkd; else if ((i & 3) == 2) o[i >> 2].z = pkd; else o[i >> 2].w = pkd; }
                u32x4* dst = (u32x4*)(cD + (size_t)crow * 1024 + ck0 + (hi ? 32 : 0));
#pragma unroll
                for (int j2 = 0; j2 < 4; ++j2) dst[j2] = o[j2];
            };
            conv_load(lw);
            for (int ci = 0; ci < 66; ++ci) {
                const float M127 = fmaxf(pmx, mcar), mnew = btot + M127;
                const int cnx = ci + 1 < 66 ? ci + 1 : 65;
                prefetch(cnx);
                commitK((ci & 1) ? S_K0 : S_K1);
                if (ci < 48) conv_store();
                conv_load(lw + 1024 * ((ci + 1) % 48));
                LDS_BARRIER();
                mcar = mnew;
                commitQ(); commitV(mcar, (ci & 1) ? S_VA0 : S_VA1); btot = pbt; pmx = ppx;
                LDS_BARRIER();
            }
        } else {
            int c = lane & 15, q = lane >> 4; asm volatile("" : "+v"(c), "+v"(q));
            const int ta = w, tb = 7 - w, trA = 16 * ta + c, trB = 16 * tb + c;
            unsigned kadA[8];
#pragma unroll
            for (int ks = 0; ks < 4; ++ks)
#pragma unroll
                for (int t = 0; t < 2; ++t) kadA[ks * 2 + t] = (unsigned)((32 * ks + 8 * q + 4 * t + (c >> 2)) * SP + (4 * w + ((c & 3) >> 1)) * 16 + 8 * (c & 1));
            f32x4 accC[2][3];
#pragma unroll
            for (int d2 = 0; d2 < 2; ++d2)
#pragma unroll
                for (int i = 0; i < 3; ++i) accC[d2][i] = (f32x4){0.f, 0.f, 0.f, 0.f};
            float mcar = 0.f, pbt, ppx;
            { const int base0 = chunk_base(0); pbt = CH[(hd * 528 + (base0 >> 7)) * 2]; ppx = CH[(hd * 528 + (base0 >> 7)) * 2 + 1]; }
            LDS_BARRIER();
            float btot = pbt, pmx = ppx;
            LDS_BARRIER();
            const int npA = (ta + 2) >> 1, npB = (tb + 2) >> 1;
            for (int ci = 0; ci < 66; ++ci) {
                const int base = chunk_base(ci); const bool store = ci >= 2, more = ci + 1 < 66;
                const int kcur = (ci & 1) ? S_K1 : S_K0, vacur = (ci & 1) ? S_VA1 : S_VA0;
                const float M127 = fmaxf(pmx, mcar), cd = __expf(mcar - M127), mnew = btot + M127;
                { const int basen = chunk_base(more ? ci + 1 : ci); pbt = CH[(hd * 528 + (basen >> 7)) * 2]; ppx = CH[(hd * 528 + (basen >> 7)) * 2 + 1]; }
                bf16x8 qfA[4], qfB[4];
                f32x4 acc3A[3], acc3B[3];
                {
                    bf16x8 cf[3][4];
#pragma unroll
                    for (int ks = 0; ks < 4; ++ks) { qfA[ks] = *(const LAS bf16x8*)(L + S_QS + trA * SP + (ks * 32 + q * 8) * 2); qfB[ks] = *(const LAS bf16x8*)(L + S_QS + trB * SP + (ks * 32 + q * 8) * 2); }
#pragma unroll
                    for (int mt = 0; mt < 3; ++mt)
#pragma unroll
                        for (int ks = 0; ks < 4; ++ks) cf[mt][ks] = *(const LAS bf16x8*)(L + S_CT + (16 * mt + c) * SP + (ks * 32 + q * 8) * 2);
                    LDS_WAIT(); __builtin_amdgcn_sched_barrier(0);
#pragma unroll
                    for (int mt = 0; mt < 3; ++mt) { acc3A[mt] = (f32x4){0.f, 0.f, 0.f, 0.f}; acc3B[mt] = (f32x4){0.f, 0.f, 0.f, 0.f};
#pragma unroll
                        for (int ks = 0; ks < 4; ++ks) { acc3A[mt] = __builtin_amdgcn_mfma_f32_16x16x32_bf16(cf[mt][ks], qfA[ks], acc3A[mt], 0, 0, 0); acc3B[mt] = __builtin_amdgcn_mfma_f32_16x16x32_bf16(cf[mt][ks], qfB[ks], acc3B[mt], 0, 0, 0); } }
                }
                const float MtA = fmaxf(PML[trA], mcar), MtB = fmaxf(PML[trB], mcar);
                const float decA = __expf(mcar - MtA), emtA = __expf(-(BL[trA] + MtA)), decB = __expf(mcar - MtB), emtB = __expf(-(BL[trB] + MtB));
                {
                    bf16x8 kf[2][4];
#pragma unroll
                    for (int u = 0; u < 2; ++u)
#pragma unroll
                        for (int ks = 0; ks < 4; ++ks) kf[u][ks] = *(const LAS bf16x8*)(L + kcur + (16 * u + c) * SP + (ks * 32 + q * 8) * 2);
                    for (int pr = 0; pr < npB; ++pr) {
                        LDS_WAIT(); __builtin_amdgcn_sched_barrier(0);
                        const bool doA = pr < npA;
                        f32x4 apA[2], apB[2], glv[2];
#pragma unroll
                        for (int u = 0; u < 2; ++u) glv[u] = *(const LAS f32x4*)(GL + 16 * (2 * pr + u) + 4 * q);
#pragma unroll
                        for (int u = 0; u < 2; ++u) { apA[u] = (f32x4){0.f, 0.f, 0.f, 0.f}; apB[u] = (f32x4){0.f, 0.f, 0.f, 0.f};
#pragma unroll
                            for (int ks = 0; ks < 4; ++ks) apB[u] = __builtin_amdgcn_mfma_f32_16x16x32_bf16(kf[u][ks], qfB[ks], apB[u], 0, 0, 0);
                            if (doA) {
#pragma unroll
                                for (int ks = 0; ks < 4; ++ks) apA[u] = __builtin_amdgcn_mfma_f32_16x16x32_bf16(kf[u][ks], qfA[ks], apA[u], 0, 0, 0); } }
                        __builtin_amdgcn_sched_barrier(0);
                        if (pr + 1 < npB) {
#pragma unroll
                            for (int u = 0; u < 2; ++u)
#pragma unroll
                                for (int ks = 0; ks < 4; ++ks) kf[u][ks] = *(const LAS bf16x8*)(L + kcur + (16 * (2 * pr + 2 + u) + c) * SP + (ks * 32 + q * 8) * 2);
                        }
#pragma unroll
                        for (int u = 0; u < 2; ++u) { const int s0 = 16 * (2 * pr + u) + 4 * q;
                            float r[4];
#pragma unroll
                            for (int j = 0; j < 4; ++j) r[j] = (s0 + j <= trB) ? apB[u][j] * __expf(glv[u][j] - MtB) : 0.f;
                            u32x2 o; o.x = pg8::cvt_pk_bf16(r[0], r[1]); o.y = pg8::cvt_pk_bf16(r[2], r[3]);
                            *(LAS u32x2*)(L + S_QS + trB * SP + s0 * 2) = o;
                            if (doA) {
#pragma unroll
                                for (int j = 0; j < 4; ++j) r[j] = (s0 + j <= trA) ? apA[u][j] * __expf(glv[u][j] - MtA) : 0.f;
                                o.x = pg8::cvt_pk_bf16(r[0], r[1]); o.y = pg8::cvt_pk_bf16(r[2], r[3]);
                                *(LAS u32x2*)(L + S_QS + trA * SP + s0 * 2) = o; } }
                    }
                }
                LDS_WAIT();
                f32x4 acc2A[3], acc2B[3];
#pragma unroll
                for (int mt = 0; mt < 3; ++mt) { acc2A[mt] = (f32x4){0.f, 0.f, 0.f, 0.f}; acc2B[mt] = (f32x4){0.f, 0.f, 0.f, 0.f}; }
                for (int ks = 0; ks < npB; ++ks) {
                    bf16x8 vf[3];
#pragma unroll
                    for (int mt = 0; mt < 3; ++mt) vf[mt] = *(const LAS bf16x8*)(L + S_VT + (16 * mt + c) * SP + (ks * 32 + q * 8) * 2);
                    const bf16x8 sB = *(const LAS bf16x8*)(L + S_QS + trB * SP + (ks * 32 + q * 8) * 2);
#pragma unroll
                    for (int mt = 0; mt < 3; ++mt) acc2B[mt] = __builtin_amdgcn_mfma_f32_16x16x32_bf16(vf[mt], sB, acc2B[mt], 0, 0, 0);
                    if (ks < npA) { const bf16x8 sA = *(const LAS bf16x8*)(L + S_QS + trA * SP + (ks * 32 + q * 8) * 2);
#pragma unroll
                        for (int mt = 0; mt < 3; ++mt) acc2A[mt] = __builtin_amdgcn_mfma_f32_16x16x32_bf16(vf[mt], sA, acc2A[mt], 0, 0, 0); }
                }
                {
                    const float denA = __shfl(acc2A[2][0] + decA * acc3A[2][0], c), denB = __shfl(acc2B[2][0] + decB * acc3B[2][0], c);
                    const float invA = frcp_(fmaxf(fabsf(denA), emtA)), invB = frcp_(fmaxf(fabsf(denB), emtB));
                    { bf16* HXs = store ? HX : (bf16*)(a.ws + WS_H2) - (size_t)T * 512;
                        const int lnh = c + 16 * q, pfh = (lnh >> 2) & 15, pqh = lnh & 3, bah = 4 * (pfh + 16 * pqh);
                        const int tokA = base + (dir ? 127 - (16 * ta + pfh) : (16 * ta + pfh)), tokB = base + (dir ? 127 - (16 * tb + pfh) : (16 * tb + pfh));
#pragma unroll
                        for (int mt = 0; mt < 2; ++mt) { const f32x4 vA = (acc2A[mt] + acc3A[mt] * decA) * invA, vB = (acc2B[mt] + acc3B[mt] * decB) * invB;
                            u32x2 o; o.x = pg8::cvt_pk_bf16(vA[0], vA[1]); o.y = pg8::cvt_pk_bf16(vA[2], vA[3]);
                            o.x = (unsigned)__builtin_amdgcn_ds_bpermute(bah, (int)o.x); o.y = (unsigned)__builtin_amdgcn_ds_bpermute(bah, (int)o.y);
                            *(u32x2*)(HXs + (size_t)tokA * 512 + h * 128 + vs * 32 + 16 * mt + 4 * pqh) = o;
                            o.x = pg8::cvt_pk_bf16(vB[0], vB[1]); o.y = pg8::cvt_pk_bf16(vB[2], vB[3]);
                            o.x = (unsigned)__builtin_amdgcn_ds_bpermute(bah, (int)o.x); o.y = (unsigned)__builtin_amdgcn_ds_bpermute(bah, (int)o.y);
                            *(u32x2*)(HXs + (size_t)tokB * 512 + h * 128 + vs * 32 + 16 * mt + 4 * pqh) = o; } }
                }
                LDS_BARRIER();
                {
                    bf16x8 vf[3][4];
#pragma unroll
                    for (int nt = 0; nt < 3; ++nt)
#pragma unroll
                        for (int ks = 0; ks < 4; ++ks) vf[nt][ks] = *(const LAS bf16x8*)(L + vacur + (16 * nt + c) * SP + (ks * 32 + q * 8) * 2);
#pragma unroll
                    for (int d2 = 0; d2 < 2; ++d2) {
                        unsigned ka[8];
#pragma unroll
                        for (int i = 0; i < 8; ++i) ka[i] = Lb + (unsigned)kcur + kadA[i] + (d2 ? 32u : 0u);
                        u32x2 kr[8]; tr_read_k8(kr, ka);
#pragma unroll
                        for (int nt = 0; nt < 3; ++nt) accC[d2][nt] = accC[d2][nt] * cd;
#pragma unroll
                        for (int ks = 0; ks < 4; ++ks) { const bf16x8 af = mk_frag(kr[ks * 2], kr[ks * 2 + 1]);
#pragma unroll
                            for (int nt = 0; nt < 3; ++nt) accC[d2][nt] = __builtin_amdgcn_mfma_f32_16x16x32_bf16(af, vf[nt][ks], accC[d2][nt], 0, 0, 0); }
#pragma unroll
                        for (int nt = 0; nt < 3; ++nt) { u32x2 o; o.x = pk2(accC[d2][nt][0], accC[d2][nt][1]); o.y = pk2(accC[d2][nt][2], accC[d2][nt][3]);
                            *(LAS u32x2*)(L + S_CT + (16 * nt + c) * SP + (16 * (2 * w + d2) + 4 * q) * 2) = o; }
                    }
                }
                mcar = mnew;
                btot = pbt; pmx = ppx;
                LDS_BARRIER();
            }
        }
    }
}

__device__ __forceinline__ void p5_pool_yb(const Args& a, const Frame& F) {
    const bf16* PP = (const bf16*)(a.ws + WS_PPOOL); bf16* PO_ = (bf16*)(a.ws + WS_POOLED);
    LAS unsigned char* L = F.lds;
    for (int item = F.bid; item < T / 64; item += F.G) {
        __syncthreads();
#pragma unroll
        for (int i = 0; i < 8; ++i) { const int p = F.tid + 512 * i, row = p >> 6, c16 = p & 63; *(LAS u32x4*)(L + row * 1024 + c16 * 16) = *(const u32x4*)(PP + (size_t)(item * 64 + row) * 512 + c16 * 8); }
        __syncthreads();
        const int cg = F.tid & 63, seg = F.tid >> 6, half = 1 << (cg >> 4), p0 = seg * 8;
        float sum[8];
#pragma unroll
        for (int j = 0; j < 8; ++j) sum[j] = 0.f;
        int lo = (p0 - half) > 0 ? (p0 - half) : 0, hi = (p0 + half) < 64 ? (p0 + half) : 64;
        for (int s2 = lo; s2 < hi; ++s2) { const u32x4 u = *(const LAS u32x4*)(L + s2 * 1024 + cg * 16);
            sum[0] += bflo(u.x); sum[1] += bfhi(u.x); sum[2] += bflo(u.y); sum[3] += bfhi(u.y); sum[4] += bflo(u.z); sum[5] += bfhi(u.z); sum[6] += bflo(u.w); sum[7] += bfhi(u.w); }
        for (int p = p0; p < p0 + 8; ++p) {
            const u32x4 u = *(const LAS u32x4*)(L + p * 1024 + cg * 16);
            const float ic = frcp_((float)(hi - lo));
            u32x4 o; o.x = pk2(sum[0] * ic - bflo(u.x), sum[1] * ic - bfhi(u.x)); o.y = pk2(sum[2] * ic - bflo(u.y), sum[3] * ic - bfhi(u.y));
            o.z = pk2(sum[4] * ic - bflo(u.z), sum[5] * ic - bfhi(u.z)); o.w = pk2(sum[6] * ic - bflo(u.w), sum[7] * ic - bfhi(u.w));
            *(u32x4*)(PO_ + (size_t)(item * 64 + p) * 512 + cg * 8) = o;
            const int nlo = (p + 1 - half) > 0 ? (p + 1 - half) : 0, nhi = (p + 1 + half) < 64 ? (p + 1 + half) : 64;
            if (nhi > hi) { const u32x4 v = *(const LAS u32x4*)(L + hi * 1024 + cg * 16);
                sum[0] += bflo(v.x); sum[1] += bfhi(v.x); sum[2] += bflo(v.y); sum[3] += bfhi(v.y); sum[4] += bflo(v.z); sum[5] += bfhi(v.z); sum[6] += bflo(v.w); sum[7] += bfhi(v.w); hi = nhi; }
            if (nlo > lo) { const u32x4 v = *(const LAS u32x4*)(L + lo * 1024 + cg * 16);
                sum[0] -= bflo(v.x); sum[1] -= bfhi(v.x); sum[2] -= bflo(v.y); sum[3] -= bfhi(v.y); sum[4] -= bflo(v.z); sum[5] -= bfhi(v.z); sum[6] -= bflo(v.w); sum[7] -= bfhi(v.w); lo = nlo; }
        }
    }
    const bf16* HF = (const bf16*)(a.ws + WS_HF); const bf16* HB = (const bf16*)(a.ws + WS_HB); const bf16* POg = (const bf16*)(a.ws + WS_PO); bf16* YB = (bf16*)(a.ws + WS_YB);
    const int gw = F.bid * 8 + F.wave, NGW = F.G * 8;
    const f32x4 hw0 = *(const f32x4*)(a.in[IN_HNW] + F.lane * 8), hw1 = *(const f32x4*)(a.in[IN_HNW] + F.lane * 8 + 4);
    const float hwv[8] = {hw0.x, hw0.y, hw0.z, hw0.w, hw1.x, hw1.y, hw1.z, hw1.w};
    for (int t0 = gw * 4; t0 < T; t0 += NGW * 4) {
        u32x4 f[4], bk[4], og[4];
#pragma unroll
        for (int u = 0; u < 4; ++u) { const size_t o = (size_t)(t0 + u) * 512 + F.lane * 8; f[u] = *(const u32x4*)(HF + o); bk[u] = *(const u32x4*)(HB + o); og[u] = *(const u32x4*)(POg + o); }
#pragma unroll
        for (int u = 0; u < 4; ++u) {
            float v[8];
            v[0] = bflo(f[u].x) + bflo(bk[u].x); v[1] = bfhi(f[u].x) + bfhi(bk[u].x); v[2] = bflo(f[u].y) + bflo(bk[u].y); v[3] = bfhi(f[u].y) + bfhi(bk[u].y);
            v[4] = bflo(f[u].z) + bflo(bk[u].z); v[5] = bfhi(f[u].z) + bfhi(bk[u].z); v[6] = bflo(f[u].w) + bflo(bk[u].w); v[7] = bfhi(f[u].w) + bfhi(bk[u].w);
            float s2 = 0.f;
#pragma unroll
            for (int jj = 0; jj < 8; ++jj) s2 += v[jj] * v[jj];
#pragma unroll
            for (int o = 1; o < 16; o <<= 1) s2 += __shfl_xor(s2, o);
            const float rstd = rsqrtf(s2 * (1.f / 128.f) + EPS);
            float gsig[8];
            gsig[0] = sigmoidf_(bflo(og[u].x)); gsig[1] = sigmoidf_(bfhi(og[u].x)); gsig[2] = sigmoidf_(bflo(og[u].y)); gsig[3] = sigmoidf_(bfhi(og[u].y));
            gsig[4] = sigmoidf_(bflo(og[u].z)); gsig[5] = sigmoidf_(bfhi(og[u].z)); gsig[6] = sigmoidf_(bflo(og[u].w)); gsig[7] = sigmoidf_(bfhi(og[u].w));
            float r[8];
#pragma unroll
            for (int jj = 0; jj < 8; ++jj) r[jj] = v[jj] * rstd * hwv[jj] * gsig[jj];
            u32x4 wv; wv.x = pg8::cvt_pk_bf16(r[0], r[1]); wv.y = pg8::cvt_pk_bf16(r[2], r[3]); wv.z = pg8::cvt_pk_bf16(r[4], r[5]); wv.w = pg8::cvt_pk_bf16(r[6], r[7]);
            *(u32x4*)(YB + (size_t)(t0 + u) * 512 + F.lane * 8) = wv;
        }
    }
}

__device__ __forceinline__ void moe_tables(const Args& a, const Frame& F) {
    LAS int* pst = (LAS int*)(F.misc + LM_PSTART); LAS unsigned char* tg = F.misc + LM_TILEG; LAS int* cxs = (LAS int*)(F.misc + LM_CX);
    LAS int* tmp = (LAS int*)F.lds; LAS int* Cpre = (LAS int*)(F.lds + 32768); LAS int* seg = (LAS int*)(F.lds + 65792);
    const int* cnt = (const int*)(a.ws + WS_CBASE);
    __syncthreads();
    for (int i = F.tid; i < 8192; i += 512) tmp[i] = cnt[i];
    if (F.tid == 0) cxs[0] = CX_MIN;
    __syncthreads();
    { const int e = F.tid & 31, sg = F.tid >> 5; int sacc = 0;
#pragma unroll
        for (int k = 0; k < 16; ++k) sacc += tmp[(sg * 16 + k) * 32 + e];
        seg[sg * 32 + e] = sacc; }
    __syncthreads();
    { const int e = F.tid & 31, sg = F.tid >> 5; int run = 0;
        for (int s2 = 0; s2 < sg; ++s2) run += seg[s2 * 32 + e];
#pragma unroll
        for (int k = 0; k < 16; ++k) { Cpre[(sg * 16 + k) * 32 + e] = run; run += tmp[(sg * 16 + k) * 32 + e]; }
        if (sg == 15) Cpre[256 * 32 + e] = run; }
    __syncthreads();
    if (F.tid >= CX_MIN && F.tid <= CX_MAX) { int tiles = 0, tilesb = 0;
        for (int e = 0; e < 32; ++e) { tiles += (Cpre[F.tid * 32 + e] + 255) >> 8; tilesb += (Cpre[256 * 32 + e] - Cpre[F.tid * 32 + e] + 255) >> 8; }
        if (tiles <= 512) atomicMax((int*)cxs, ((4095 - (tiles + tilesb)) << 8) | F.tid); }
    __syncthreads();
    if (F.tid == 0) { const int cx = cxs[0] & 255; cxs[0] = cx; int acc = 0;
        for (int g = 0; g < NGRP; ++g) { pst[g] = acc; const int e = g & 31; const int c2 = g < 32 ? Cpre[cx * 32 + e] : Cpre[256 * 32 + e] - Cpre[cx * 32 + e]; acc += (c2 + 255) & ~255; }
        pst[NGRP] = acc; }
    __syncthreads();
    if (F.tid < NGRP) { const int t0 = pst[F.tid] >> 8, t1 = pst[F.tid + 1] >> 8; for (int t = t0; t < t1; ++t) tg[t] = (unsigned char)F.tid; }
    __syncthreads();
}

__device__ __forceinline__ void moe_tables_load(const Args& a, const Frame& F) {
    LAS int* pst = (LAS int*)(F.misc + LM_PSTART); LAS unsigned char* tg = F.misc + LM_TILEG; LAS int* cxs = (LAS int*)(F.misc + LM_CX);
    const int* tab = (const int*)(a.ws + WS_MOETAB);
    __syncthreads();
    if (F.tid < 65) pst[F.tid] = tab[F.tid];
    if (F.tid == 65) cxs[0] = tab[65];
    if (F.tid >= 128 && F.tid < 128 + 288) ((LAS int*)tg)[F.tid - 128] = tab[128 + F.tid - 128];
    __syncthreads();
}
__device__ __forceinline__ unsigned okey(float v) { const unsigned b = __float_as_uint(v); return b ^ ((unsigned)((int)b >> 31) | 0x80000000u); }
__device__ __forceinline__ float okey_inv(unsigned o) { return __uint_as_float((o & 0x80000000u) ? (o ^ 0x80000000u) : ~o); }
__device__ __forceinline__ unsigned rowmax16(unsigned x) {
    unsigned y;
    y = (unsigned)__builtin_amdgcn_update_dpp(0, (int)x, 0x128, 0xf, 0xf, false); x = x > y ? x : y;
    y = (unsigned)__builtin_amdgcn_update_dpp(0, (int)x, 0x124, 0xf, 0xf, false); x = x > y ? x : y;
    y = (unsigned)__builtin_amdgcn_update_dpp(0, (int)x, 0x122, 0xf, 0xf, false); x = x > y ? x : y;
    y = (unsigned)__builtin_amdgcn_update_dpp(0, (int)x, 0x121, 0xf, 0xf, false); x = x > y ? x : y;
    return x; }
__device__ __forceinline__ void p9_router(const Args& a, const Frame& F) {
    LAS unsigned char* Whi = F.lds; LAS unsigned char* Wlo = F.lds + 65536;
    LAS float* NWS = (LAS float*)(F.lds + 131072); LAS float* SHV = (LAS float*)(F.lds + 135168);
    LAS int* hist = (LAS int*)(F.lds + 139264);
    LAS float* red = (LAS float*)(F.lds + 139392);
    LAS f32x4* accb = (LAS f32x4*)(F.lds + 139904);
    const float* mod = (const float*)(a.ws + WS_MOD); bf16* H2 = (bf16*)(a.ws + WS_H2);
    int* cntg = (int*)(a.ws + WS_CBASE);
    int* ent_g = (int*)(a.ws + WS_ENT_G); int* ent_pos = (int*)(a.ws + WS_ENT_POS); float* ent_w = (float*)(a.ws + WS_ENT_W);
    const bf16* wr = (const bf16*)(a.ws + WS_WR_T);
    __syncthreads();
    for (int i = F.tid; i < 2 * 32 * 128; i += 512) { const int part = i >> 12, r = (i >> 7) & 31, c16 = i & 127;
        *(LAS u32x4*)((part ? Wlo : Whi) + r * 2048 + ((c16 ^ (r & 15)) << 4)) = *(const u32x4*)(wr + (size_t)part * 32768 + r * 1024 + c16 * 8); }
    const int c = F.lane & 15, q = F.lane >> 4, pair = F.wave >> 1;
    const float br0 = a.in[IN_BR][c], br1 = a.in[IN_BR][16 + c];
    for (int chunk = F.bid; chunk < T / 256; chunk += F.G) {
        const int bidx = (chunk * 256) >> 13;
        __syncthreads();
        if (F.tid < 32) hist[F.tid] = 0;
        for (int k = F.tid; k < 1024; k += 512) { NWS[k] = a.in[IN_N2W][k] * (1.0f + mod[bidx * 6144 + 4096 + k]); SHV[k] = mod[bidx * 6144 + 3072 + k]; }
        __syncthreads();
        for (int st = 0; st < 4; ++st) {
            const int tl0 = (st * 4 + pair) * 16, r = chunk * 256 + tl0 + c;
            f32x4 acc[2]; acc[0] = (f32x4){0.f, 0.f, 0.f, 0.f}; acc[1] = (f32x4){0.f, 0.f, 0.f, 0.f};
            norm_pair<2, true>(x1_row(a.out, a.ws, chunk * 256 + tl0 + ((F.lane >> 2) & 15)), NWS, SHV, H2 + (size_t)(chunk * 256 + tl0 + ((F.lane >> 2) & 15)) * D, Whi, Wlo, red, F.wave, c, q, acc);
            if (F.wave & 1) accb[pair * 64 + F.lane] = acc[0];
            LDS_BARRIER();
            if (!(F.wave & 1)) acc[0] += accb[pair * 64 + F.lane];
            LDS_BARRIER();
            if (F.wave & 1) accb[pair * 64 + F.lane] = acc[1];
            LDS_BARRIER();
            if (!(F.wave & 1)) {
                acc[1] += accb[pair * 64 + F.lane];
#pragma unroll
                for (int j = 0; j < 4; ++j) {
                    float v0 = acc[0][j] + br0, v1 = acc[1][j] + br1;
                    float tv[4]; int ti[4];
                    unsigned k0 = (okey(v0) & ~31u) | (unsigned)(31 - c), k1 = (okey(v1) & ~31u) | (unsigned)(15 - c);
#pragma unroll
                    for (int k = 0; k < 4; ++k) {
                        const unsigned mx = rowmax16(k0 > k1 ? k0 : k1);
                        ti[k] = 31 - (int)(mx & 31u); tv[k] = okey_inv(mx & ~31u);
                        k0 = (k0 == mx) ? 0u : k0; k1 = (k1 == mx) ? 0u : k1;
                    }
                    const float e1 = __expf(tv[1] - tv[0]), e2 = __expf(tv[2] - tv[0]), e3 = __expf(tv[3] - tv[0]); const float inv = 1.0f / (1.0f + e1 + e2 + e3);
                    if (c < 4) { const int e = c == 0 ? ti[0] : c == 1 ? ti[1] : c == 2 ? ti[2] : ti[3]; const float wgt = (c == 0 ? 1.0f : c == 1 ? e1 : c == 2 ? e2 : e3) * inv;
                        const int lp = atomicAdd((int*)(hist + e), 1);
                        const size_t gi = (size_t)(chunk * 256 + tl0 + 4 * q + j) * 4 + c; ent_g[gi] = e; ent_pos[gi] = lp; ent_w[gi] = wgt; }
                }
            }
        }
        __syncthreads();
        if (F.tid < 32) cntg[chunk * 32 + F.tid] = hist[F.tid];
    }
}

__device__ __forceinline__ void p10_scatter(const Args& a, const Frame& F) {
    moe_tables(a, F);
    LAS int* pst = (LAS int*)(F.misc + LM_PSTART); const LAS int* Cpre = (const LAS int*)(F.lds + 32768);
    const int cx = ((const LAS int*)(F.misc + LM_CX))[0];
    if (F.bid == 0) { int* tab = (int*)(a.ws + WS_MOETAB);
        if (F.tid < 65) tab[F.tid] = pst[F.tid];
        if (F.tid == 65) tab[65] = cx;
        if (F.tid >= 128 && F.tid < 128 + 288) tab[128 + F.tid - 128] = ((const LAS int*)(F.misc + LM_TILEG))[F.tid - 128]; }
    const int* ent_g = (const int*)(a.ws + WS_ENT_G); const int* ent_pos = (const int*)(a.ws + WS_ENT_POS);
    int* row_tok = (int*)(a.ws + WS_ROW_TOK); int* tok_row = (int*)(a.ws + WS_TOK_ROW);
    for (int idx = F.bid * 512 + F.tid; idx < T * 4; idx += F.G * 512) {
        const int e = ent_g[idx], chunk = idx >> 10, part = chunk >= cx ? 1 : 0, t = idx >> 2;
        const int r = pst[part * 32 + e] + Cpre[chunk * 32 + e] - (part ? Cpre[cx * 32 + e] : 0) + ent_pos[idx];
        row_tok[r] = t; tok_row[idx] = r;
    }
    for (int g = F.bid; g < NGRP; g += F.G) { const int e = g & 31; const int c2 = g < 32 ? Cpre[cx * 32 + e] : Cpre[256 * 32 + e] - Cpre[cx * 32 + e]; const int r0 = pst[g] + c2, r1 = pst[g + 1];
        for (int r = r0 + F.tid; r < r1; r += 512) row_tok[r] = 0; }
}

__device__ __forceinline__ void p_final(const Args& a, const Frame& F, int half) {
    moe_tables_load(a, F);
    const int rowbase = half ? ((const LAS int*)(F.misc + LM_PSTART))[32] : 0;
    const int X = 256 * ((const LAS int*)(F.misc + LM_CX))[0], tbeg = half ? X : 0, tend = half ? T : X;
    const float* mod = (const float*)(a.ws + WS_MOD); const bf16* OUTK = (const bf16*)(a.ws + WS_OUTK);
    const int* tok_row = (const int*)(a.ws + WS_TOK_ROW); const float* ent_w = (const float*)(a.ws + WS_ENT_W);
    const int gw = F.bid * 8 + F.wave, NGW = F.G * 8;
    const f32x4* fw = (const f32x4*)a.in[IN_FNW] + F.lane;
    int rkn[4]; float wkn[4];
    { const int t0 = tbeg + gw; if (t0 < tend) {
#pragma unroll
        for (int k = 0; k < 4; ++k) { rkn[k] = tok_row[t0 * 4 + k] - rowbase; wkn[k] = ent_w[t0 * 4 + k]; } } }
    for (int t = tbeg + gw; t < tend; t += NGW) {
        f32x4* xr = (f32x4*)(a.out + (size_t)t * D) + F.lane;
        const u32x2* x1p = (const u32x2*)x1_row(a.out, a.ws, t) + F.lane;
        const f32x4* g2 = (const f32x4*)(mod + (t >> 13) * 6144 + 5120) + F.lane;
        int rk[4]; float wk[4];
#pragma unroll
        for (int k = 0; k < 4; ++k) { rk[k] = rkn[k]; wk[k] = wkn[k]; }
        u32x2 ok[4][4], xw[4];
#pragma unroll
        for (int j = 0; j < 4; ++j) { xw[j] = x1p[64 * j];
#pragma unroll
            for (int k = 0; k < 4; ++k) ok[j][k] = *((const u32x2*)(OUTK + (size_t)rk[k] * D) + F.lane + 64 * j); }
        { const int tn = t + NGW; if (tn < tend) {
#pragma unroll
            for (int k = 0; k < 4; ++k) { rkn[k] = tok_row[tn * 4 + k] - rowbase; wkn[k] = ent_w[tn * 4 + k]; } } }
        f32x4 v[4]; float s = 0.f;
#pragma unroll
        for (int j = 0; j < 4; ++j) {
            f32x4 m = (f32x4){0.f, 0.f, 0.f, 0.f};
#pragma unroll
            for (int k = 0; k < 4; ++k) { const u32x2 o = ok[j][k]; m.x += wk[k] * bflo(o.x); m.y += wk[k] * bfhi(o.x); m.z += wk[k] * bflo(o.y); m.w += wk[k] * bfhi(o.y); }
            v[j] = (f32x4){bflo(xw[j].x), bfhi(xw[j].x), bflo(xw[j].y), bfhi(xw[j].y)} + g2[64 * j] * m;
            s += (v[j].x * v[j].x + v[j].y * v[j].y) + (v[j].z * v[j].z + v[j].w * v[j].w);
        }
        const float rstd = rsqrtf(wave_sum(s) * (1.f / D) + EPS);
#pragma unroll
        for (int j = 0; j < 4; ++j) xr[64 * j] = v[j] * rstd * fw[64 * j];
    }
}

__global__ void __launch_bounds__(512, 2) mk_fwd(Args args) {
    extern __shared__ __attribute__((aligned(16))) unsigned char lds_raw[];
    Frame F;
    F.lds = (LAS unsigned char*)lds_raw; F.misc = F.lds + LDS_MAIN;
    F.tid = threadIdx.x; F.lane = F.tid & 63; F.wave = __builtin_amdgcn_readfirstlane(F.tid >> 6); F.G = gridDim.x; F.bid = blockIdx.x;
    unsigned char* ws = args.ws;
    const int lo = args.ph_lo, hi = args.ph_hi;
    if (F.tid < 4) ((LAS unsigned*)(F.misc + LM_BAR))[F.tid] = 0u;
    __syncthreads();
    XcdBarrier bar; bar.bar = (unsigned*)(ws + WS_CTL) + CW_BAR; bar.x = 0; bar.st = nullptr;
    if (hi - lo > 1) bar = xcd_barrier_post((unsigned*)(ws + WS_CTL) + CW_BAR, (volatile LAS unsigned*)(F.misc + LM_BAR));
#define IN(k) (lo <= (k) && (k) < hi)
#define SEAM(k) do { if (IN(k) && IN((k) + 1)) xcd_barrier(bar); } while (0)

    if (IN(0)) { p0_prologue(args, F); } SEAM(0);
    if (IN(1)) { p1_xn(args, F); } SEAM(1);
    if (IN(2)) {
        pg8::Gemm g{(const bf16*)(ws + WS_XN), (const bf16*)(ws + WS_WIN_T), 1024, nullptr, nullptr, nullptr};
        SchedIn S{F.G, F.bid};
        EpiIn E{(bf16*)(ws + WS_PPOOL), (bf16*)(ws + WS_PQK), (bf16*)(ws + WS_PV), (bf16*)(ws + WS_PO), ws + WS_PMERGE};
        pg8::gemm_phase<EpiIn, SchedIn, false>(F.lds, g, S, E);
        { const int nctx = 48 < F.G ? 48 : 0;
          if (F.bid >= nctx) gate_scans(args, F, nctx, F.G - nctx); }
    } SEAM(2);
    if (IN(3)) { p3_conv(args, F); } SEAM(3);
    if (IN(4)) { p4_scan(args, F); } SEAM(4);
    if (IN(5)) { p5_pool_yb(args, F); } SEAM(5);
    if (IN(6)) {
        pg8::Gemm g{(const bf16*)(ws + WS_POOLED), (const bf16*)(ws + WS_WPA_T), 512, nullptr, (const bf16*)(ws + WS_YB), (const bf16*)(ws + WS_WBM_T)};
        SchedMerge S{F.G, F.bid};
        EpiMerge E{(const unsigned char*)(ws + WS_PMERGE), (bf16*)(ws + WS_Y)};
        pg8::gemm_phase<EpiMerge, SchedMerge, false, true>(F.lds, g, S, E);
    } SEAM(6);
    if (IN(8)) {
        pg8::Gemm g{(const bf16*)(ws + WS_Y), (const bf16*)(ws + WS_WOUT_T), 1024, nullptr, nullptr, nullptr};
        pg8::StaticOrder S{256, 4, F.G, F.bid};
        EpiOut E{args.in[IN_X], (const float*)(ws + WS_MOD), args.out, ws};
        pg8::gemm_phase<EpiOut, pg8::StaticOrder, false>(F.lds, g, S, E);
    } SEAM(8);
    if (IN(9)) { p9_router(args, F); } SEAM(9);
    if (IN(10)) { p10_scatter(args, F); } SEAM(10);
    if (IN(11)) {
        moe_tables_load(args, F);
        const LAS int* pst = (const LAS int*)(F.misc + LM_PSTART);
        pg8::Gemm g{(const bf16*)(ws + WS_H2), (const bf16*)(ws + WS_W1T), 1024, (const int*)(ws + WS_ROW_TOK), nullptr, nullptr};
        SchedMoe S{F.G, F.bid, 8, 0, pst[NGRP] >> 8, (const LAS unsigned char*)(F.misc + LM_TILEG)};
        EpiMoe1 E{args.in[IN_B1], (bf16*)(ws + WS_ACT)};
        pg8::gemm_phase<EpiMoe1, SchedMoe, true>(F.lds, g, S, E);
    } SEAM(11);
    if (IN(12)) {
        moe_tables_load(args, F);
        const LAS int* pst = (const LAS int*)(F.misc + LM_PSTART);
        pg8::Gemm g{(const bf16*)(ws + WS_ACT), (const bf16*)(ws + WS_W2T), 1024, nullptr, nullptr, nullptr};
        SchedMoe S{F.G, F.bid, 4, 0, pst[32] >> 8, (const LAS unsigned char*)(F.misc + LM_TILEG)};
        EpiMoe2 E{args.in[IN_B2], (bf16*)(ws + WS_OUTK), 0};
        pg8::gemm_phase<EpiMoe2, SchedMoe, false>(F.lds, g, S, E);
    } SEAM(12);
    if (IN(13)) { p_final(args, F, 0); } SEAM(13);
    if (IN(14)) {
        moe_tables_load(args, F);
        const LAS int* pst = (const LAS int*)(F.misc + LM_PSTART);
        pg8::Gemm g{(const bf16*)(ws + WS_ACT), (const bf16*)(ws + WS_W2T), 1024, nullptr, nullptr, nullptr};
        SchedMoe S{F.G, F.bid, 4, pst[32] >> 8, pst[NGRP] >> 8, (const LAS unsigned char*)(F.misc + LM_TILEG)};
        EpiMoe2 E{args.in[IN_B2], (bf16*)(ws + WS_OUTK), pst[32]};
        pg8::gemm_phase<EpiMoe2, SchedMoe, false>(F.lds, g, S, E);
    } SEAM(14);
    if (IN(15)) { p_final(args, F, 1); }
#undef IN
#undef SEAM
}

extern "C" void kernel_launch(void* const* d_in, const int* in_sizes, int n_in, void* d_out, int out_size, void* d_ws, size_t ws_size, hipStream_t stream) {
    static int grid = 0;
    if (grid == 0) {
        if (n_in != 25 || out_size != T * D || ws_size < WS_END) { fprintf(stderr, "kernel_launch: unexpected shapes (n_in %d out %d ws %zu)\n", n_in, out_size, ws_size); grid = -1; return; }
        int dev = 0, cus = 0, per_cu = 0;
        if (hipGetDevice(&dev) != hipSuccess || hipDeviceGetAttribute(&cus, hipDeviceAttributeMultiprocessorCount, dev) != hipSuccess) { grid = -1; return; }
        if (hipFuncSetAttribute((const void*)mk_fwd, hipFuncAttributeMaxDynamicSharedMemorySize, LDS_BYTES) != hipSuccess) { fprintf(stderr, "kernel_launch: hipFuncSetAttribute failed\n"); grid = -1; return; }
        if (hipOccupancyMaxActiveBlocksPerMultiprocessor(&per_cu, (const void*)mk_fwd, 512, LDS_BYTES) != hipSuccess || per_cu < 1) fprintf(stderr, "kernel_launch: occupancy query says %d\n", per_cu);
        (void)hipGetLastError();
        grid = cus;
    }
    if (grid < 0) return;
    (void)hipMemsetAsync((char*)d_ws + WS_CTL, 0, CTL_BYTES, stream);
    Args a{};
    for (int i = 0; i < 25; ++i) a.in[i] = (const float*)d_in[i];
    a.out = (float*)d_out; a.ws = (unsigned char*)d_ws;
#if MK_MULTI
    for (int p = 0; p < NPHASE; ++p) { a.ph_lo = p; a.ph_hi = p + 1; hipLaunchKernelGGL(mk_fwd, dim3(grid), dim3(512), LDS_BYTES, stream, a); }
#else
    a.ph_lo = 0; a.ph_hi = NPHASE;
    hipLaunchKernelGGL(mk_fwd, dim3(grid), dim3(512), LDS_BYTES, stream, a);
#endif
}
```
